# Optimizing an MI355X kernel written in HIP

```python
import jax, jax.numpy as jnp
from jax import lax
import numpy as np

D_MODEL = 2048
BATCH = 2
SEQ = 16384
DEPTH = 1
DEC_BATCH = 16
DEC_SEQ = 64
PAST_LEN = 1024

CHUNK = 64
D_CONV = 1024
CONV_WIDTH = 3
HGRN_HEADS = 16
HGRN_DK = 128
HGRN_DV = 128
D_HGRN = HGRN_HEADS * HGRN_DK
N_BRANCH = 2
D_FF = 5632
HGRN_BLOCK = 16
NORM_EPS = 1e-6
D_IN = 3 * D_CONV + 4 * D_HGRN + N_BRANCH * D_MODEL

kernel_name = "hybrid_shortconv_hgrn2_macaron_step"


def rms_norm(x, g):
    xf = x.astype(jnp.float32)
    r = lax.rsqrt(jnp.mean(xf * xf, axis=-1, keepdims=True) + NORM_EPS)
    return (xf * r * g.astype(jnp.float32)).astype(x.dtype)


def swiglu(h, w_gate, w_up, w_down):
    return (jax.nn.silu(h @ w_gate) * (h @ w_up)) @ w_down


def causal_conv(u, buf, w):
    t = u.shape[1]
    full = jnp.concatenate([buf.astype(u.dtype), u], axis=1)
    y = w[0] * full[:, 0:t]
    for j in range(1, CONV_WIDTH):
        y = y + w[j] * full[:, j:j + t]
    return y, full[:, -(CONV_WIDTH - 1):]


def hgrn2_recurrence(q, logf, k, v, s0):
    b, t, h, dk = q.shape
    dv = v.shape[-1]
    n = -(-t // HGRN_BLOCK)
    pad = n * HGRN_BLOCK - t
    padw = ((0, 0), (0, pad), (0, 0), (0, 0))

    def blocks(a):
        a = jnp.pad(a, padw)
        return a.reshape(b, n, HGRN_BLOCK, h, a.shape[-1]).transpose(1, 0, 2, 3, 4)

    mask = jnp.tril(jnp.ones((HGRN_BLOCK, HGRN_BLOCK), dtype=bool))

    def step(s, blk):
        qb, gb, kb, vb = blk
        g_cum = jnp.cumsum(gb, axis=1)
        g_last = g_cum[:, -1]
        q_dec = qb * jnp.exp(g_cum)
        k_inv = kb * jnp.exp(-g_cum)
        k_end = kb * jnp.exp(g_last[:, None] - g_cum)
        a = jnp.einsum('blhk,bshk->bhls', q_dec, k_inv)
        a = jnp.where(mask, a, 0.0)
        o = (jnp.einsum('bhls,bshv->blhv', a, vb)
             + jnp.einsum('blhk,bhkv->blhv', q_dec, s))
        s_new = jnp.exp(g_last)[..., None] * s + jnp.einsum('bshk,bshv->bhkv', k_end, vb)
        return s_new, o

    s_fin, o = lax.scan(step, s0.astype(jnp.float32),
                        (blocks(q), blocks(logf), blocks(k), blocks(v)))
    o = o.transpose(1, 0, 2, 3, 4).reshape(b, n * HGRN_BLOCK, h, dv)[:, :t]
    return o, s_fin


def token_mixing(h, lb, conv_buf, s_hgrn, w_in, conv_w, hgrn_norm, w_br_conv, w_br_hgrn, w_out):
    b, t, _ = h.shape
    proj = h @ w_in
    idx = list(np.cumsum([D_CONV, D_CONV, D_CONV, D_HGRN, D_HGRN, D_HGRN, D_HGRN, D_MODEL]))
    gb, gc, vc, q, fz, iv, og, g_conv, g_hgrn = jnp.split(proj, idx, axis=-1)

    conv_y, new_buf = causal_conv(gc * vc, conv_buf, conv_w)
    y_conv = gb * conv_y

    f = lb + (1.0 - lb) * jax.nn.sigmoid(fz.astype(jnp.float32))
    logf = jnp.log(f)
    kk = 1.0 - f
    qf = jax.nn.silu(q.astype(jnp.float32))
    heads = lambda a: a.reshape(b, t, HGRN_HEADS, -1)
    o, new_s = hgrn2_recurrence(heads(qf), heads(logf), heads(kk),
                                heads(iv.astype(jnp.float32)), s_hgrn)
    o = o * lax.rsqrt(jnp.mean(o * o, axis=-1, keepdims=True) + NORM_EPS)
    o = o * hgrn_norm.astype(jnp.float32).reshape(HGRN_HEADS, HGRN_DV)
    y_hgrn = (o.reshape(b, t, D_HGRN) * jax.nn.silu(og.astype(jnp.float32))).astype(h.dtype)

    merged = (jax.nn.sigmoid(g_conv) * (y_conv @ w_br_conv)
              + jax.nn.sigmoid(g_hgrn) * (y_hgrn @ w_br_hgrn))
    return merged @ w_out, new_buf, new_s


def trunk(x, conv_bufs, hgrn_states, w):
    lb_all = jnp.cumsum(jax.nn.softmax(w['hgrn_lb_logits'].astype(jnp.float32), axis=0), axis=0)
    new_convs, new_states = [], []
    for l in range(DEPTH):
        hn = rms_norm(x, w['norm_ffn1'][l])
        x = x + 0.5 * swiglu(hn, w['w_ffn1_gate'][l], w['w_ffn1_up'][l], w['w_ffn1_down'][l])
        hn = rms_norm(x, w['norm_mix'][l])
        m, nb, ns = token_mixing(hn, lb_all[l], conv_bufs[l], hgrn_states[l], w['w_in'][l],
                                 w['conv_w'][l], w['hgrn_norm'][l], w['w_br_conv'][l],
                                 w['w_br_hgrn'][l], w['w_out'][l])
        x = x + m
        hn = rms_norm(x, w['norm_ffn2'][l])
        x = x + 0.5 * swiglu(hn, w['w_ffn2_gate'][l], w['w_ffn2_up'][l], w['w_ffn2_down'][l])
        new_convs.append(nb)
        new_states.append(ns)
    y = rms_norm(x, w['norm_final'])
    return y, jnp.stack(new_convs), jnp.stack(new_states)


def setup_inputs(seed: int = 0) -> dict:
    key = jax.random.key(seed)
    ks = jax.random.split(key, 24)
    nrm = lambda k, shape, s: jax.random.normal(k, shape, jnp.float32) * s
    gain = lambda k, shape: 1.0 + 0.01 * jax.random.normal(k, shape, jnp.float32)
    L = DEPTH
    return {
        "x_prompt": nrm(ks[0], (BATCH, SEQ, D_MODEL), 1.0),
        "x_sample": nrm(ks[1], (DEC_BATCH, DEC_SEQ, D_MODEL), 1.0),
        "cache_conv": nrm(ks[2], (L, DEC_BATCH, CONV_WIDTH - 1, D_CONV), 1.0),
        "state_hgrn": nrm(ks[3], (L, DEC_BATCH, HGRN_HEADS, HGRN_DK, HGRN_DV), 0.5),
        "norm_ffn1": gain(ks[4], (L, D_MODEL)),
        "w_ffn1_gate": nrm(ks[5], (L, D_MODEL, D_FF), D_MODEL ** -0.5),
        "w_ffn1_up": nrm(ks[6], (L, D_MODEL, D_FF), D_MODEL ** -0.5),
        "w_ffn1_down": nrm(ks[7], (L, D_FF, D_MODEL), D_FF ** -0.5),
        "norm_mix": gain(ks[8], (L, D_MODEL)),
        "w_in": nrm(ks[9], (L, D_MODEL, D_IN), D_MODEL ** -0.5),
        "conv_w": nrm(ks[10], (L, CONV_WIDTH, D_CONV), CONV_WIDTH ** -0.5),
        "hgrn_lb_logits": nrm(ks[11], (L + 1, D_HGRN), 0.1),
        "hgrn_norm": gain(ks[12], (L, D_HGRN)),
        "w_br_conv": nrm(ks[13], (L, D_CONV, D_MODEL), D_CONV ** -0.5),
        "w_br_hgrn": nrm(ks[14], (L, D_HGRN, D_MODEL), D_HGRN ** -0.5),
        "w_out": nrm(ks[15], (L, D_MODEL, D_MODEL), D_MODEL ** -0.5),
        "norm_ffn2": gain(ks[16], (L, D_MODEL)),
        "w_ffn2_gate": nrm(ks[17], (L, D_MODEL, D_FF), D_MODEL ** -0.5),
        "w_ffn2_up": nrm(ks[18], (L, D_MODEL, D_FF), D_MODEL ** -0.5),
        "w_ffn2_down": nrm(ks[19], (L, D_FF, D_MODEL), D_FF ** -0.5),
        "norm_final": gain(ks[20], (D_MODEL,)),
    }


def reference(x_prompt, x_sample, cache_conv, state_hgrn, norm_ffn1, w_ffn1_gate, w_ffn1_up,
              w_ffn1_down, norm_mix, w_in, conv_w, hgrn_lb_logits, hgrn_norm, w_br_conv,
              w_br_hgrn, w_out, norm_ffn2, w_ffn2_gate, w_ffn2_up, w_ffn2_down, norm_final):
    w = dict(norm_ffn1=norm_ffn1, w_ffn1_gate=w_ffn1_gate, w_ffn1_up=w_ffn1_up,
             w_ffn1_down=w_ffn1_down, norm_mix=norm_mix, w_in=w_in, conv_w=conv_w,
             hgrn_lb_logits=hgrn_lb_logits, hgrn_norm=hgrn_norm, w_br_conv=w_br_conv,
             w_br_hgrn=w_br_hgrn, w_out=w_out, norm_ffn2=norm_ffn2, w_ffn2_gate=w_ffn2_gate,
             w_ffn2_up=w_ffn2_up, w_ffn2_down=w_ffn2_down, norm_final=norm_final)
    zero_conv = jnp.zeros((DEPTH, x_prompt.shape[0], CONV_WIDTH - 1, D_CONV), x_prompt.dtype)
    zero_hgrn = jnp.zeros((DEPTH, x_prompt.shape[0], HGRN_HEADS, HGRN_DK, HGRN_DV), jnp.float32)
    y_prompt, new_conv_prompt, new_hgrn_prompt = trunk(x_prompt, zero_conv, zero_hgrn, w)
    y_sample, new_conv_sample, new_hgrn_sample = trunk(x_sample, cache_conv, state_hgrn, w)
    return (y_prompt, y_sample, new_conv_prompt, new_hgrn_prompt, new_conv_sample, new_hgrn_sample)
```

```cpp
#include <hip/hip_runtime.h>
#include <hip/hip_cooperative_groups.h>
#include <cstdio>
#include <cstdint>
namespace cg = cooperative_groups;
namespace pg8 {
#define PG8_LAS __attribute__((address_space(3)))
typedef unsigned short bf16_t;
typedef short bf16x8 __attribute__((ext_vector_type(8)));
typedef float f32x4 __attribute__((ext_vector_type(4)));
typedef unsigned u32x4 __attribute__((ext_vector_type(4)));
constexpr int BM = 256, BK = 64, HALF = 128, HTB = HALF * BK * 2  , STAGE_BYTES = 8 * HTB, NXCD = 8, WGM = 8;

__host__ __device__ __forceinline__ int lds_byte(int r, int c) { const int st = (r >> 4) * 2 + (c >> 5), rr = r & 15, cc = c & 31, ob = rr * 64 + cc * 2; return st * 1024 + (ob ^ (((ob >> 9) & 1) << 5)); }
__host__ __device__ __forceinline__ void stage_rc(int b, int& R, int& C) { const int st = b / 1024, sb = b % 1024, swz = sb ^ (((sb >> 9) & 1) << 5); R = (st >> 1) * 16 + swz / 64; C = (st & 1) * 32 + (swz % 64) / 2; }
__host__ __device__ __forceinline__ int perm32(int rho) { const int n = rho >> 4, i = rho & 15; return 8 * (i >> 2) + 4 * n + (i & 3); }

struct Unit { int pm, pn, kt0, nkt, part, lj; };
struct Gemm { const bf16_t* A; const bf16_t* Bt; int M, N, K; };

__host__ __device__ __forceinline__ void tile_of(int nM, int nN, int wgid, int& pm, int& pn) {
    const int nwg = nM * nN;
    { const int q = nwg / NXCD, r = nwg % NXCD, xcd = wgid % NXCD, off = wgid / NXCD; wgid = (xcd < r ? xcd * (q + 1) : r * (q + 1) + (xcd - r) * q) + off; }
    const int nig = WGM * nN, gid = wgid / nig, fm = gid * WGM, gsz = (nM - fm) < WGM ? (nM - fm) : WGM;
    pm = fm + ((wgid % nig) % gsz); pn = (wgid % nig) / gsz;
}
struct StaticOrder {
    int nM, nN, nwg, G, c, nt, split;
    __host__ __device__ void init(int M, int N, int G_, int c_, int nt_, int split_ = 0) { nM = M / BM; nN = N / BM; nwg = nM * nN; G = G_; c = c_; nt = nt_; split = split_; }
    __host__ __device__ bool next(int i, Unit& u) const {
        int wgid; u.kt0 = 0; u.nkt = nt; u.part = 0; u.lj = -1;
        const int fr_ = nwg / G, rem = nwg - fr_ * G;
        if (split > 1 && rem > 0 && rem * split <= G && i == fr_) { const int j = c / split; if (j >= rem) return false; wgid = fr_ * G + j; u.nkt = nt / split; u.part = c % split; u.kt0 = u.part * u.nkt; u.lj = j; }
        else { const long L = (long)i * G + c; if (L >= nwg) return false; wgid = (int)L; }
        tile_of(nM, nN, wgid, u.pm, u.pn); return true;
    }
    __device__ __forceinline__ void a_ready(const Unit&) const {}
    __device__ __forceinline__ void done(const Unit&) const {}
};

typedef __bf16 bf16v2_t __attribute__((ext_vector_type(2))); typedef float f32v2_t __attribute__((ext_vector_type(2)));
__device__ __forceinline__ unsigned cvt_pk_bf16(float lo, float hi) { const f32v2_t v = {lo, hi}; return __builtin_bit_cast(unsigned, __builtin_convertvector(v, bf16v2_t)); }
__device__ __forceinline__ float bf_lo(unsigned u) { return __uint_as_float(u << 16); }
__device__ __forceinline__ float bf_hi(unsigned u) { return __uint_as_float(u & 0xffff0000u); }
__device__ __forceinline__ float fast_sigmoid(float x) { return __builtin_amdgcn_rcpf(1.0f + __builtin_amdgcn_exp2f(-1.44269504f * x)); }
__device__ __forceinline__ float fast_silu(float x) { return x * fast_sigmoid(x); }
typedef unsigned u32x2 __attribute__((ext_vector_type(2)));

struct EpiSwiGLU {
    static constexpr bool PERM = true, AFTER_DRAIN = false;
    bf16_t* H; int ldh;
    __device__ __forceinline__ void operator()(const f32x4 (&acc)[2][2][4][2], const Unit& u, int wr, int wc, int fr, int fq) const {
        const int row0 = u.pm * BM + wr * 64 + fr, col0 = u.pn * HALF + wc * 32 + 8 * fq;
#pragma unroll
        for (int ai = 0; ai < 2; ++ai)
#pragma unroll
            for (int m = 0; m < 4; ++m) {
                bf16_t* rowp = H + (size_t)(row0 + ai * HALF + m * 16) * ldh + col0;
                float h[8];
#pragma unroll
                for (int n = 0; n < 2; ++n)
#pragma unroll
                    for (int j = 0; j < 4; ++j) h[n * 4 + j] = fast_silu(acc[ai][0][m][n][j]) * acc[ai][1][m][n][j];
                u32x4 w; w.x = cvt_pk_bf16(h[0], h[1]); w.y = cvt_pk_bf16(h[2], h[3]); w.z = cvt_pk_bf16(h[4], h[5]); w.w = cvt_pk_bf16(h[6], h[7]);
                *(u32x4*)rowp = w;
            }
    }
};
struct EpiRes {
    static constexpr bool PERM = false, AFTER_DRAIN = false;
    const float* base0; const float* base1; int split; float* out; int ldc; float scale;
    __device__ __forceinline__ void operator()(const f32x4 (&acc)[2][2][4][2], const Unit& u, int wr, int wc, int fr, int fq) const {
        const int row0 = u.pm * BM + wr * 64 + fr, col0 = u.pn * BM + wc * 32 + 4 * fq;
        const float* bs = (u.pm * BM < split) ? base0 : base1 - (size_t)split * ldc;
#pragma unroll
        for (int ai = 0; ai < 2; ++ai) {
            f32x4 b[4][2][2];
#pragma unroll
            for (int m = 0; m < 4; ++m) { const size_t off = (size_t)(row0 + ai * HALF + m * 16) * ldc + col0;
#pragma unroll
                for (int bj = 0; bj < 2; ++bj)
#pragma unroll
                    for (int n = 0; n < 2; ++n) b[m][bj][n] = *(const f32x4*)(bs + off + bj * HALF + n * 16); }
#pragma unroll
            for (int m = 0; m < 4; ++m) { const size_t off = (size_t)(row0 + ai * HALF + m * 16) * ldc + col0;
#pragma unroll
                for (int bj = 0; bj < 2; ++bj)
#pragma unroll
                    for (int n = 0; n < 2; ++n) *(f32x4*)(out + off + bj * HALF + n * 16) = b[m][bj][n] + acc[ai][bj][m][n] * scale; }
            asm volatile("" ::: "memory");
        }
    }
};
struct EpiDelta {
    static constexpr bool PERM = true, AFTER_DRAIN = false;
    bf16_t* D; int ldc; float scale; bf16_t* X; int nx;
    __device__ __forceinline__ void operator()(const f32x4 (&acc)[2][2][4][2], const Unit& u, int wr, int wc, int fr, int fq) const {
        bf16_t* base; int pitch;
        if (u.part > 0) { base = X + ((size_t)(u.lj * nx + u.part - 1) << 16) + (size_t)(wr * 64 + fr) * 256 + wc * 32 + 8 * fq; pitch = 256; }
        else { base = D + (size_t)(u.pm * BM + wr * 64 + fr) * ldc + u.pn * BM + wc * 32 + 8 * fq; pitch = ldc; }
#pragma unroll
        for (int ai = 0; ai < 2; ++ai)
#pragma unroll
            for (int m = 0; m < 4; ++m) { bf16_t* rowp = base + (size_t)(ai * HALF + m * 16) * pitch;
#pragma unroll
                for (int bj = 0; bj < 2; ++bj) { const f32x4 v0 = acc[ai][bj][m][0] * scale, v1 = acc[ai][bj][m][1] * scale;
                    u32x4 w; w.x = cvt_pk_bf16(v0[0], v0[1]); w.y = cvt_pk_bf16(v0[2], v0[3]); w.z = cvt_pk_bf16(v1[0], v1[1]); w.w = cvt_pk_bf16(v1[2], v1[3]);
                    *(u32x4*)(rowp + bj * HALF) = w; } }
    }
};
struct EpiProj {
    static constexpr bool PERM = true, AFTER_DRAIN = false;
    bf16_t *GB, *GC, *VC, *Q, *FZ, *IV, *OG, *SGC, *SGH;
    __device__ __forceinline__ void operator()(const f32x4 (&acc)[2][2][4][2], const Unit& u, int wr, int wc, int fr, int fq) const {
        const int pn = u.pn; bf16_t* base; int ldc, colt, act;
        if (pn < 4) { base = GB; ldc = 1024; colt = pn * 256; act = 0; }
        else if (pn < 8) { base = GC; ldc = 1024; colt = (pn - 4) * 256; act = 0; }
        else if (pn < 12) { base = VC; ldc = 1024; colt = (pn - 8) * 256; act = 0; }
        else if (pn < 20) { base = Q; ldc = 2048; colt = (pn - 12) * 256; act = 1; }
        else if (pn < 28) { base = FZ; ldc = 2048; colt = (pn - 20) * 256; act = 0; }
        else if (pn < 36) { base = IV; ldc = 2048; colt = (pn - 28) * 256; act = 0; }
        else if (pn < 44) { base = OG; ldc = 2048; colt = (pn - 36) * 256; act = 1; }
        else if (pn < 52) { base = SGC; ldc = 2048; colt = (pn - 44) * 256; act = 2; }
        else { base = SGH; ldc = 2048; colt = (pn - 52) * 256; act = 2; }
        const int row0 = u.pm * BM + wr * 64 + fr, col0 = colt + wc * 32 + 8 * fq;
#pragma unroll
        for (int ai = 0; ai < 2; ++ai)
#pragma unroll
            for (int m = 0; m < 4; ++m) { bf16_t* rowp = base + (size_t)(row0 + ai * HALF + m * 16) * ldc + col0;
#pragma unroll
                for (int bj = 0; bj < 2; ++bj) { float v[8];
#pragma unroll
                    for (int n = 0; n < 2; ++n)
#pragma unroll
                        for (int j = 0; j < 4; ++j) { const float x = acc[ai][bj][m][n][j]; v[n * 4 + j] = (act == 0) ? x : (act == 1 ? fast_silu(x) : fast_sigmoid(x)); }
                    u32x4 w; w.x = cvt_pk_bf16(v[0], v[1]); w.y = cvt_pk_bf16(v[2], v[3]); w.z = cvt_pk_bf16(v[4], v[5]); w.w = cvt_pk_bf16(v[6], v[7]);
                    *(u32x4*)(rowp + bj * HALF) = w; } }
    }
};
template <bool ACCUM> struct EpiMerge {
    static constexpr bool PERM = true, AFTER_DRAIN = false;
    const bf16_t* G; bf16_t* O;
    __device__ __forceinline__ void operator()(const f32x4 (&acc)[2][2][4][2], const Unit& u, int wr, int wc, int fr, int fq) const {
        const int row0 = u.pm * BM + wr * 64 + fr, col0 = u.pn * BM + wc * 32 + 8 * fq;
#pragma unroll
        for (int ai = 0; ai < 2; ++ai)
#pragma unroll
            for (int m = 0; m < 4; ++m) { const size_t off = (size_t)(row0 + ai * HALF + m * 16) * 2048 + col0;
#pragma unroll
                for (int bj = 0; bj < 2; ++bj) { const u32x4 g = *(const u32x4*)(G + off + bj * HALF); float v[8];
                    v[0] = bf_lo(g.x) * acc[ai][bj][m][0][0]; v[1] = bf_hi(g.x) * acc[ai][bj][m][0][1]; v[2] = bf_lo(g.y) * acc[ai][bj][m][0][2]; v[3] = bf_hi(g.y) * acc[ai][bj][m][0][3];
                    v[4] = bf_lo(g.z) * acc[ai][bj][m][1][0]; v[5] = bf_hi(g.z) * acc[ai][bj][m][1][1]; v[6] = bf_lo(g.w) * acc[ai][bj][m][1][2]; v[7] = bf_hi(g.w) * acc[ai][bj][m][1][3];
                    if (ACCUM) { const u32x4 p = *(const u32x4*)(O + off + bj * HALF);
                        v[0] += bf_lo(p.x); v[1] += bf_hi(p.x); v[2] += bf_lo(p.y); v[3] += bf_hi(p.y); v[4] += bf_lo(p.z); v[5] += bf_hi(p.z); v[6] += bf_lo(p.w); v[7] += bf_hi(p.w); }
                    u32x4 w; w.x = cvt_pk_bf16(v[0], v[1]); w.y = cvt_pk_bf16(v[2], v[3]); w.z = cvt_pk_bf16(v[4], v[5]); w.w = cvt_pk_bf16(v[6], v[7]);
                    *(u32x4*)(O + off + bj * HALF) = w; } }
    }
};
template <class Epi, class Sched, bool ALIGN_EPI = false, bool SP2 = false>
__device__ __forceinline__ void gemm_phase(PG8_LAS unsigned char* lds, const Gemm g, const Sched& S, const Epi& E) {
    int tid_ = threadIdx.x; asm volatile("" : "+v"(tid_));
    const int tid = tid_, wid = __builtin_amdgcn_readfirstlane(tid >> 6), lane = tid & 63, wr = wid >> 2, wc = wid & 3, fr = lane & 15, fq = lane >> 4;
    const int K = g.K;
    unsigned voffA[2], voffB[2];
#pragma unroll
    for (int i = 0; i < 2; ++i) { int R, C; stage_rc(tid * 16 + i * 8192, R, C); const int Rb = Epi::PERM ? ((R & ~31) + perm32(R & 31)) : R;
        voffA[i] = (unsigned)(R * K + C) * 2u; voffB[i] = (unsigned)(Rb * K + C) * 2u; }
    const size_t kstep = (size_t)(BK * 2);
    const size_t hstep = (size_t)HALF * K * 2;
    const size_t tstep = 2 * hstep;
    const unsigned ldsw = (unsigned)wid * 1024u;
    const int aoff = lds_byte(wr * 64 + fr, fq * 8), boff = lds_byte(wc * 32 + fr, fq * 8);
#define PG8_SA(b, h) (((b) * 2 + (h)) * HTB)
#define PG8_SB(b, h) ((4 + (b) * 2 + (h)) * HTB)
#define PG8_STAGE(bufoff, gbase, voff) do { _Pragma("unroll") for (int _i = 0; _i < 2; ++_i) \
        __builtin_amdgcn_global_load_lds((const unsigned*)((const char*)(gbase) + (voff)[_i]), (PG8_LAS unsigned*)(lds + (bufoff) + ldsw + _i * 8192), 16, 0, 0); } while (0)
#define PG8_LDA(dst, b, h) do { _Pragma("unroll") for (int m = 0; m < 4; ++m) _Pragma("unroll") for (int k = 0; k < 2; ++k) dst[m][k] = *(const PG8_LAS bf16x8*)(lds + PG8_SA(b, h) + aoff + m * 2048 + k * 1024); } while (0)
#define PG8_LDB(dst, b, h) do { _Pragma("unroll") for (int n = 0; n < 2; ++n) _Pragma("unroll") for (int k = 0; k < 2; ++k) dst[n][k] = *(const PG8_LAS bf16x8*)(lds + PG8_SB(b, h) + boff + n * 2048 + k * 1024); } while (0)
#define PG8_MMA(ai, bj, At, Bt) do { __builtin_amdgcn_s_setprio(1); _Pragma("unroll") for (int m = 0; m < 4; ++m) _Pragma("unroll") for (int n = 0; n < 2; ++n) _Pragma("unroll") for (int k = 0; k < 2; ++k) \
        acc[ai][bj][m][n] = __builtin_amdgcn_mfma_f32_16x16x32_bf16(Bt[n][k], At[m][k], acc[ai][bj][m][n], 0, 0, 0); __builtin_amdgcn_s_setprio(0); } while (0)
#define PG8_WAIT_V(n) asm volatile("s_waitcnt vmcnt(" #n ")" ::: "memory")
#define PG8_WAIT_L(n) asm volatile("s_waitcnt lgkmcnt(" #n ")" ::: "memory")
#define PG8_BAR __builtin_amdgcn_s_barrier()
#define PG8_SCHED __builtin_amdgcn_sched_barrier(0)
    Unit cur, nxt; int ui = 0;
    if (!S.next(0, cur)) return;
    f32x4 acc[2][2][4][2];
#pragma unroll
    for (int a = 0; a < 2; ++a)
#pragma unroll
        for (int b = 0; b < 2; ++b)
#pragma unroll
            for (int m = 0; m < 4; ++m)
#pragma unroll
                for (int n = 0; n < 2; ++n) acc[a][b][m][n] = (f32x4){0.f, 0.f, 0.f, 0.f};
    bf16x8 At[4][2], B0[2][2], B1[2][2];
    const char* cA = (const char*)g.A + (size_t)cur.pm * tstep + (size_t)cur.kt0 * kstep; const char* cB = (const char*)g.Bt + (size_t)cur.pn * tstep + (size_t)cur.kt0 * kstep;
    S.a_ready(cur);
    if constexpr (SP2) {
        PG8_STAGE(PG8_SB(0, 0), cB, voffB); PG8_STAGE(PG8_SB(0, 1), cB + hstep, voffB); PG8_STAGE(PG8_SA(0, 0), cA, voffA); PG8_STAGE(PG8_SA(0, 1), cA + hstep, voffA);
        if (wr == 1) PG8_BAR;
        PG8_WAIT_V(2); PG8_BAR;
        PG8_STAGE(PG8_SB(1, 0), cB + kstep, voffB); PG8_STAGE(PG8_SA(1, 0), cA + kstep, voffA); PG8_STAGE(PG8_SB(1, 1), cB + hstep + kstep, voffB);
        PG8_WAIT_V(6); PG8_BAR;
    } else {
        PG8_STAGE(PG8_SB(0, 0), cB, voffB); PG8_STAGE(PG8_SA(0, 0), cA, voffA); PG8_STAGE(PG8_SB(0, 1), cB + hstep, voffB); PG8_STAGE(PG8_SA(0, 1), cA + hstep, voffA);
        if (wr == 1) PG8_BAR;
        PG8_WAIT_V(4); PG8_BAR;
        PG8_STAGE(PG8_SB(1, 0), cB + kstep, voffB); PG8_STAGE(PG8_SA(1, 0), cA + kstep, voffA); PG8_STAGE(PG8_SB(1, 1), cB + hstep + kstep, voffB);
        PG8_WAIT_V(6); PG8_BAR;
    }
    for (;;) {
        const bool has_next = S.next(ui + 1, nxt);
        const char* nA = has_next ? (const char*)g.A + (size_t)nxt.pm * tstep + (size_t)nxt.kt0 * kstep : cA; const char* nB = has_next ? (const char*)g.Bt + (size_t)nxt.pn * tstep + (size_t)nxt.kt0 * kstep : cB;
        const int nt = cur.nkt;
        for (int t = 0; t < nt; t += 2) {
            const bool last = (t == nt - 2);
            const char* a1 = cA + (size_t)(t + 1) * kstep;
            const char* a2 = last ? nA : cA + (size_t)(t + 2) * kstep; const char* b2 = last ? nB : cB + (size_t)(t + 2) * kstep;
            const char* a3 = a2 + kstep; const char* b3 = b2 + kstep;
            if (last && has_next) S.a_ready(nxt);
            if constexpr (SP2) {
            PG8_LDB(B0, 0, 0); PG8_LDB(B1, 0, 1); PG8_SCHED; PG8_LDA(At, 0, 0); PG8_STAGE(PG8_SA(1, 1), a1 + hstep, voffA);
            PG8_WAIT_V(8); PG8_WAIT_L(0); PG8_BAR; PG8_MMA(0, 0, At, B0); PG8_MMA(0, 1, At, B1); PG8_BAR; PG8_SCHED;
            PG8_LDA(At, 0, 1); PG8_STAGE(PG8_SB(0, 0), b2, voffB); PG8_STAGE(PG8_SB(0, 1), b2 + hstep, voffB); PG8_STAGE(PG8_SA(0, 0), a2, voffA);
            PG8_WAIT_V(8); PG8_WAIT_L(0); PG8_BAR; PG8_MMA(1, 0, At, B0); PG8_MMA(1, 1, At, B1); PG8_BAR; PG8_SCHED;
            PG8_LDB(B0, 1, 0); PG8_LDB(B1, 1, 1); PG8_SCHED; PG8_LDA(At, 1, 0); PG8_STAGE(PG8_SA(0, 1), a2 + hstep, voffA);
            PG8_WAIT_V(8); PG8_WAIT_L(0); PG8_BAR; PG8_MMA(0, 0, At, B0); PG8_MMA(0, 1, At, B1); PG8_BAR; PG8_SCHED;
            PG8_LDA(At, 1, 1); PG8_STAGE(PG8_SB(1, 0), b3, voffB); PG8_STAGE(PG8_SB(1, 1), b3 + hstep, voffB); PG8_STAGE(PG8_SA(1, 0), a3, voffA);
            PG8_WAIT_V(8); PG8_WAIT_L(0); PG8_BAR; PG8_MMA(1, 0, At, B0); PG8_MMA(1, 1, At, B1); PG8_BAR; PG8_SCHED;
            } else {
            PG8_LDB(B0, 0, 0); PG8_SCHED; PG8_LDA(At, 0, 0); PG8_STAGE(PG8_SA(1, 1), a1 + hstep, voffA);
            PG8_WAIT_L(8); PG8_BAR; PG8_WAIT_L(0); PG8_MMA(0, 0, At, B0); PG8_BAR; PG8_SCHED;
            PG8_LDB(B1, 0, 1); PG8_STAGE(PG8_SB(0, 0), b2, voffB);
            PG8_BAR; PG8_WAIT_L(0); PG8_MMA(0, 1, At, B1); PG8_BAR;
            PG8_LDA(At, 0, 1); PG8_STAGE(PG8_SA(0, 0), a2, voffA);
            PG8_BAR; PG8_WAIT_L(0); PG8_MMA(1, 0, At, B0); PG8_BAR; PG8_SCHED;
            PG8_STAGE(PG8_SB(0, 1), b2 + hstep, voffB);
            PG8_WAIT_V(6); PG8_BAR; PG8_MMA(1, 1, At, B1); PG8_BAR;
            PG8_LDB(B0, 1, 0); PG8_SCHED; PG8_LDA(At, 1, 0); PG8_STAGE(PG8_SA(0, 1), a2 + hstep, voffA);
            PG8_WAIT_L(8); PG8_BAR; PG8_WAIT_L(0); PG8_MMA(0, 0, At, B0); PG8_BAR; PG8_SCHED;
            PG8_LDB(B1, 1, 1); PG8_STAGE(PG8_SB(1, 0), b3, voffB);
            PG8_BAR; PG8_WAIT_L(0); PG8_MMA(0, 1, At, B1); PG8_BAR;
            PG8_LDA(At, 1, 1); PG8_STAGE(PG8_SA(1, 0), a3, voffA);
            PG8_BAR; PG8_WAIT_L(0); PG8_MMA(1, 0, At, B0); PG8_BAR; PG8_SCHED;
            PG8_STAGE(PG8_SB(1, 1), b3 + hstep, voffB);
            PG8_WAIT_V(6); PG8_BAR; PG8_MMA(1, 1, At, B1); PG8_BAR;
            }
        }
        if constexpr (ALIGN_EPI) { if (wr == 0) PG8_BAR; }
        if constexpr (!Epi::AFTER_DRAIN) { E(acc, cur, wr, wc, fr, fq); S.done(cur); }
        if (!has_next) break;
#pragma unroll
        for (int a = 0; a < 2; ++a)
#pragma unroll
            for (int b = 0; b < 2; ++b)
#pragma unroll
                for (int m = 0; m < 4; ++m)
#pragma unroll
                    for (int n = 0; n < 2; ++n) acc[a][b][m][n] = (f32x4){0.f, 0.f, 0.f, 0.f};
        cur = nxt; cA = nA; cB = nB; ++ui;
        if constexpr (ALIGN_EPI) { if (wr == 1) PG8_BAR; }
    }
    PG8_WAIT_V(0);
    if constexpr (!ALIGN_EPI) { if (wr == 0) PG8_BAR; }
    PG8_BAR;
    if constexpr (Epi::AFTER_DRAIN) { E.fused(acc, cur, wr, wc, fr, fq, lds, wid, lane); S.done(cur); }
#undef PG8_SA
#undef PG8_SB
#undef PG8_STAGE
#undef PG8_LDA
#undef PG8_LDB
#undef PG8_MMA
#undef PG8_WAIT_V
#undef PG8_WAIT_L
#undef PG8_BAR
#undef PG8_SCHED
}
}
using pg8::bf_lo; using pg8::bf_hi; using pg8::fast_sigmoid; using pg8::fast_silu;
#define PG8_SP2 true
#define PG8_ALIGN true
#define LAS __attribute__((address_space(3)))
typedef unsigned short bf16;
typedef unsigned v4u __attribute__((ext_vector_type(4)));
typedef unsigned v2u __attribute__((ext_vector_type(2)));
typedef float f32x4 __attribute__((ext_vector_type(4)));
typedef float f32x2 __attribute__((ext_vector_type(2)));
typedef short bf16x8 __attribute__((ext_vector_type(8)));
constexpr int DM = 2048, SEQ = 16384, NBATCH = 2, DECB = 16, DECS = 64;
constexpr int TP = NBATCH * SEQ, TS = DECB * DECS, TT = TP + TS;
constexpr int DCV = 1024, DH = 2048, NH = 16, DFF = 5632, DIN = 15360;
constexpr float EPS = 1e-6f;
constexpr int TGMAX = 17408;
constexpr size_t MiB = 1u << 20;
constexpr size_t WS_W1GU = 1 * MiB, WS_W1D = 45 * MiB, WS_WIN = 67 * MiB, WS_WBC = 127 * MiB, WS_WBH = 131 * MiB, WS_WOUT = 139 * MiB, WS_W2GU = 147 * MiB, WS_W2D = 191 * MiB;
constexpr size_t WS_XN = 213 * MiB, WS_BIG = 345 * MiB;
constexpr size_t WS_H = WS_BIG;
constexpr size_t WS_GB = WS_BIG, WS_GC = WS_GB + 34 * MiB, WS_VC = WS_GC + 34 * MiB, WS_Q = WS_VC + 34 * MiB, WS_FZ = WS_Q + 68 * MiB, WS_IV = WS_FZ + 68 * MiB,
                 WS_OG = WS_IV + 68 * MiB, WS_SGC = WS_OG + 68 * MiB, WS_SGH = WS_SGC + 68 * MiB, WS_UT = WS_SGH + 68 * MiB, WS_D = WS_UT + 136 * MiB, WS_END = WS_D + 5 * MiB;
static_assert(WS_END <= 1024 * MiB, "workspace map");
constexpr size_t O_Y = 0, O_NCP = (size_t)TT * DM, O_NHP = O_NCP + 2 * 2 * 1024, O_NCS = O_NHP + 2 * 16 * 16384, O_NHS = O_NCS + 16 * 2 * 1024;
constexpr int LDS_BYTES = 131072 + 1024;

__device__ __forceinline__ float wave_sum(float v) {
#pragma unroll
    for (int o = 1; o < 64; o <<= 1) v += __shfl_xor(v, o);
    return v;
}
__device__ __forceinline__ int opaque_tid() { int t = threadIdx.x; asm volatile("" : "+v"(t)); return t; }
__device__ __forceinline__ unsigned f2bf(float f) { unsigned u = __builtin_bit_cast(unsigned, f); return (u + 0x7fffu + ((u >> 16) & 1u)) >> 16; }
__device__ __forceinline__ unsigned pk2(float lo, float hi) { return pg8::cvt_pk_bf16(lo, hi); }

__device__ __forceinline__ void transpose_item(const float* W, int K, int N, bf16* WT, int il, LAS float* scr, int item, int lane) {
    const int nblk = N / 32, kb = item / nblk, nb = item % nblk, k0 = 64 * kb, n0 = 32 * nb;
#pragma unroll 8
    for (int i = 0; i < 32; ++i) { const int kk = 2 * i + (lane >> 5); scr[kk * 33 + (lane & 31)] = W[(size_t)(k0 + kk) * N + n0 + (lane & 31)]; }
    asm volatile("s_waitcnt lgkmcnt(0)" ::: "memory");
    const int c = lane & 7;
    const int r0 = il ? (256 * (n0 >> 7) + 128 * (il - 1) + (n0 & 127)) : n0;
#pragma unroll
    for (int j = 0; j < 4; ++j) { const int n = (lane >> 3) + 8 * j; const LAS float* s = scr + (8 * c) * 33 + n;
        v4u o; o.x = pk2(s[0 * 33], s[1 * 33]); o.y = pk2(s[2 * 33], s[3 * 33]); o.z = pk2(s[4 * 33], s[5 * 33]); o.w = pk2(s[6 * 33], s[7 * 33]);
        *(v4u*)(WT + (size_t)(r0 + n) * K + k0 + 8 * c) = o; }
    asm volatile("s_waitcnt lgkmcnt(0)" ::: "memory");
}
__device__ __forceinline__ void rms_rows_bf16(const float* xp, const float* xs, const float* gw, bf16* XN, int row_lo, int row_hi, int gwv, int ngw, int) {
    const int lane = opaque_tid() & 63;
    for (int m = row_lo + gwv; m < row_hi; m += ngw) {
        const f32x4* xr = (const f32x4*)(m < TP ? xp + (size_t)m * DM : xs + (size_t)(m - TP) * DM) + lane;
        f32x4 v[8]; float s = 0.f;
#pragma unroll
        for (int j = 0; j < 8; ++j) { v[j] = xr[64 * j]; s += (v[j].x * v[j].x + v[j].y * v[j].y) + (v[j].z * v[j].z + v[j].w * v[j].w); }
        const float r = 1.0f / sqrtf(wave_sum(s) * (1.0f / DM) + EPS);
        v2u* o = (v2u*)(XN + (size_t)m * DM) + lane;
#pragma unroll
        for (int j = 0; j < 8; ++j) { const f32x4 g = ((const f32x4*)gw)[lane + 64 * j]; v2u w; w.x = pk2(v[j].x * r * g.x, v[j].y * r * g.y); w.y = pk2(v[j].z * r * g.z, v[j].w * r * g.w); o[64 * j] = w; }
    }
}
__device__ __forceinline__ void rms_rows_f32_inplace(float* x, const float* gw, int nrows, int gwv, int ngw, int) {
    const int lane = opaque_tid() & 63;
    for (int m = gwv; m < nrows; m += ngw) {
        f32x4* xr = (f32x4*)(x + (size_t)m * DM) + lane;
        f32x4 v[8]; float s = 0.f;
#pragma unroll
        for (int j = 0; j < 8; ++j) { v[j] = xr[64 * j]; s += (v[j].x * v[j].x + v[j].y * v[j].y) + (v[j].z * v[j].z + v[j].w * v[j].w); }
        const float r = 1.0f / sqrtf(wave_sum(s) * (1.0f / DM) + EPS);
#pragma unroll
        for (int j = 0; j < 8; ++j) { const f32x4 g = ((const f32x4*)gw)[lane + 64 * j]; xr[64 * j] = v[j] * r * g; }
    }
}

__device__ __forceinline__ void build_split_table(LAS unsigned char* tbl, int G, int nparts) {
    const int tid = opaque_tid();
    for (int i = tid; i < (TT / 256) * 8; i += 512) tbl[i] = 0;
    __syncthreads();
    const int nwg = (TT / 256) * 8, fr_ = nwg / G, rem = nwg - fr_ * G;
    if (nparts > 1 && rem > 0 && rem * nparts <= G && tid < rem) { int pm, pn; pg8::tile_of(TT / 256, 8, fr_ * G + tid, pm, pn); tbl[pm * 8 + pn] = (unsigned char)(tid + 1); }
    __syncthreads();
}
__device__ __forceinline__ void rms_rows_delta_bf16(const float* xp, const float* xs, const float* gw, bf16* XN, float* xout, int gwv, int ngw, const bf16* XS = nullptr, int nx = 0, const LAS unsigned char* tbl = nullptr) {
    const int lane = opaque_tid() & 63;
    for (int m = gwv; m < TT; m += ngw) {
        const f32x4* xr = (const f32x4*)(m < TP ? xp + (size_t)m * DM : xs + (size_t)(m - TP) * DM) + lane;
        v2u* dn = (v2u*)(XN + (size_t)m * DM) + lane; f32x4* xo = (f32x4*)(xout + (size_t)m * DM) + lane;
        f32x4 v[8]; float s = 0.f;
#pragma unroll
        for (int j = 0; j < 8; ++j) { v[j] = xr[64 * j]; const v2u d = dn[64 * j]; v[j].x += bf_lo(d.x); v[j].y += bf_hi(d.x); v[j].z += bf_lo(d.y); v[j].w += bf_hi(d.y);
            if (nx > 0) { const int t = tbl[(m >> 8) * 8 + j];
                if (t) for (int p = 0; p < nx; ++p) { const v2u e = *((const v2u*)(XS + ((size_t)((t - 1) * nx + p) << 16) + (size_t)(m & 255) * 256) + lane);
                    v[j].x += bf_lo(e.x); v[j].y += bf_hi(e.x); v[j].z += bf_lo(e.y); v[j].w += bf_hi(e.y); } }
            s += (v[j].x * v[j].x + v[j].y * v[j].y) + (v[j].z * v[j].z + v[j].w * v[j].w); }
#pragma unroll
        for (int j = 0; j < 8; ++j) xo[64 * j] = v[j];
        const float r = 1.0f / sqrtf(wave_sum(s) * (1.0f / DM) + EPS);
#pragma unroll
        for (int j = 0; j < 8; ++j) { const f32x4 g = ((const f32x4*)gw)[lane + 64 * j]; v2u w; w.x = pk2(v[j].x * r * g.x, v[j].y * r * g.y); w.y = pk2(v[j].z * r * g.z, v[j].w * r * g.w); dn[64 * j] = w; }
    }
}
__device__ __forceinline__ void rms_rows_delta_final(float* x, const bf16* XN, const float* gw, int gwv, int ngw, const bf16* XS = nullptr, int nx = 0, const LAS unsigned char* tbl = nullptr) {
    const int lane = opaque_tid() & 63;
    for (int m = gwv; m < TT; m += ngw) {
        f32x4* xr = (f32x4*)(x + (size_t)m * DM) + lane; const v2u* dn = (const v2u*)(XN + (size_t)m * DM) + lane;
        f32x4 v[8]; float s = 0.f;
#pragma unroll
        for (int j = 0; j < 8; ++j) { v[j] = xr[64 * j]; const v2u d = dn[64 * j]; v[j].x += bf_lo(d.x); v[j].y += bf_hi(d.x); v[j].z += bf_lo(d.y); v[j].w += bf_hi(d.y);
            if (nx > 0) { const int t = tbl[(m >> 8) * 8 + j];
                if (t) for (int p = 0; p < nx; ++p) { const v2u e = *((const v2u*)(XS + ((size_t)((t - 1) * nx + p) << 16) + (size_t)(m & 255) * 256) + lane);
                    v[j].x += bf_lo(e.x); v[j].y += bf_hi(e.x); v[j].z += bf_lo(e.y); v[j].w += bf_hi(e.y); } }
            s += (v[j].x * v[j].x + v[j].y * v[j].y) + (v[j].z * v[j].z + v[j].w * v[j].w); }
        const float r = 1.0f / sqrtf(wave_sum(s) * (1.0f / DM) + EPS);
#pragma unroll
        for (int j = 0; j < 8; ++j) { const f32x4 g = ((const f32x4*)gw)[lane + 64 * j]; xr[64 * j] = v[j] * r * g; }
    }
}
__device__ __forceinline__ void conv_item(int cl, bool seq_first, bool seq_last, const float* hist  , float* newc  , bf16* GB, const bf16* GC, const bf16* VC, const float* cw, int) {
    const int tid = opaque_tid(); const int c0 = 8 * (tid & 127), tq = tid >> 7; const int r0 = cl * 64 + 16 * tq;
    float um2[8], um1[8], w0[8], w1[8], w2[8];
#pragma unroll
    for (int j = 0; j < 8; ++j) { w0[j] = cw[c0 + j]; w1[j] = cw[1024 + c0 + j]; w2[j] = cw[2048 + c0 + j]; }
    if (seq_first && tq == 0) {
#pragma unroll
        for (int j = 0; j < 8; ++j) { um2[j] = hist ? hist[c0 + j] : 0.f; um1[j] = hist ? hist[1024 + c0 + j] : 0.f; }
    } else {
        const v4u a2 = *(const v4u*)(GC + (size_t)(r0 - 2) * 1024 + c0), b2 = *(const v4u*)(VC + (size_t)(r0 - 2) * 1024 + c0);
        const v4u a1 = *(const v4u*)(GC + (size_t)(r0 - 1) * 1024 + c0), b1 = *(const v4u*)(VC + (size_t)(r0 - 1) * 1024 + c0);
#pragma unroll
        for (int j = 0; j < 4; ++j) { um2[2 * j] = bf_lo(a2[j]) * bf_lo(b2[j]); um2[2 * j + 1] = bf_hi(a2[j]) * bf_hi(b2[j]); um1[2 * j] = bf_lo(a1[j]) * bf_lo(b1[j]); um1[2 * j + 1] = bf_hi(a1[j]) * bf_hi(b1[j]); }
    }
#pragma unroll 4
    for (int i = 0; i < 16; ++i) {
        const size_t off = (size_t)(r0 + i) * 1024 + c0;
        const v4u g = *(const v4u*)(GB + off), a = *(const v4u*)(GC + off), b = *(const v4u*)(VC + off);
        float y[8];
#pragma unroll
        for (int j = 0; j < 4; ++j) {
            const float u0 = bf_lo(a[j]) * bf_lo(b[j]), u1 = bf_hi(a[j]) * bf_hi(b[j]);
            y[2 * j] = bf_lo(g[j]) * (w0[2 * j] * um2[2 * j] + w1[2 * j] * um1[2 * j] + w2[2 * j] * u0);
            y[2 * j + 1] = bf_hi(g[j]) * (w0[2 * j + 1] * um2[2 * j + 1] + w1[2 * j + 1] * um1[2 * j + 1] + w2[2 * j + 1] * u1);
            um2[2 * j] = um1[2 * j]; um1[2 * j] = u0; um2[2 * j + 1] = um1[2 * j + 1]; um1[2 * j + 1] = u1;
        }
        v4u w; w.x = pk2(y[0], y[1]); w.y = pk2(y[2], y[3]); w.z = pk2(y[4], y[5]); w.w = pk2(y[6], y[7]);
        *(v4u*)(GB + off) = w;
    }
    if (seq_last && tq == 3) {
#pragma unroll
        for (int j = 0; j < 8; ++j) { newc[c0 + j] = um2[j]; newc[1024 + c0 + j] = um1[j]; }
    }
}

constexpr int H1_QD = 0, H1_KI = 17408, H1_KET = 34816, H1_VT = 53248, H1_A = 71680, H1_TOT = 80896;
__device__ __forceinline__ void h1_unit(LAS unsigned char* lds, int row0, int h, bf16* Q, bf16* FZ, const bf16* IV, bf16* UTu, float* Du, const float* lbl, int) {
    const int tid = opaque_tid(); LAS bf16* sQd = (LAS bf16*)(lds + H1_QD); LAS bf16* sKi = (LAS bf16*)(lds + H1_KI); LAS bf16* sKet = (LAS bf16*)(lds + H1_KET);
    LAS bf16* sVt = (LAS bf16*)(lds + H1_VT); LAS bf16* sA = (LAS bf16*)(lds + H1_A); LAS float* sTot = (LAS float*)(lds + H1_TOT);
    const int lane = tid & 63, w = tid >> 6, k0 = 2 * lane, fr = lane & 15, fq = lane >> 4;
    const float la0 = lbl[h * 128 + k0], la1 = lbl[h * 128 + k0 + 1], lb0_ = lbl[2048 + h * 128 + k0], lb1_ = lbl[2048 + h * 128 + k0 + 1];
    const float lbv0 = 1.0f / (1.0f + __expf(lb0_ - la0)), lbv1 = 1.0f / (1.0f + __expf(lb1_ - la1));
    const size_t gbase = (size_t)(row0 + 8 * w) * 2048 + h * 128 + k0;
    unsigned qv[8], fv[8], vv[8];
#pragma unroll
    for (int i = 0; i < 8; ++i) { qv[i] = *(const unsigned*)(Q + gbase + (size_t)i * 2048); fv[i] = *(const unsigned*)(FZ + gbase + (size_t)i * 2048); vv[i] = *(const unsigned*)(IV + gbase + (size_t)i * 2048); }
    float g0[8], g1[8], kk0[8], kk1[8]; float c0 = 0.f, c1 = 0.f;
#pragma unroll
    for (int i = 0; i < 8; ++i) {
        const float z0 = fminf(fmaxf(bf_lo(fv[i]), -30.f), 30.f), z1 = fminf(fmaxf(bf_hi(fv[i]), -30.f), 30.f);
        const float e0 = __builtin_amdgcn_exp2f(-1.44269504f * z0), e1 = __builtin_amdgcn_exp2f(-1.44269504f * z1);
        const float s0 = __builtin_amdgcn_rcpf(1.f + e0), s1 = __builtin_amdgcn_rcpf(1.f + e1);
        const float f0 = lbv0 + (1.f - lbv0) * s0, f1 = lbv1 + (1.f - lbv1) * s1;
        kk0[i] = (1.f - lbv0) * e0 * s0; kk1[i] = (1.f - lbv1) * e1 * s1;
        c0 += __builtin_amdgcn_logf(f0); c1 += __builtin_amdgcn_logf(f1); g0[i] = c0; g1[i] = c1;
    }
    sTot[w * 128 + k0] = c0; sTot[w * 128 + k0 + 1] = c1;
    __syncthreads();
    float off0 = 0.f, off1 = 0.f, tot0 = 0.f, tot1 = 0.f;
#pragma unroll
    for (int j = 0; j < 8; ++j) { const float t0 = sTot[j * 128 + k0], t1 = sTot[j * 128 + k0 + 1]; tot0 += t0; tot1 += t1; if (j < w) { off0 += t0; off1 += t1; } }
    float ke0[8], ke1[8];
#pragma unroll
    for (int i = 0; i < 8; ++i) {
        const float G0 = off0 + g0[i], G1 = off1 + g1[i];
        const float q0 = bf_lo(qv[i]), q1 = bf_hi(qv[i]);
        const unsigned qd = pk2(q0 * __builtin_amdgcn_exp2f(G0), q1 * __builtin_amdgcn_exp2f(G1));
        const unsigned ki = pk2(kk0[i] * __builtin_amdgcn_exp2f(-G0), kk1[i] * __builtin_amdgcn_exp2f(-G1));
        ke0[i] = kk0[i] * __builtin_amdgcn_exp2f(tot0 - G0); ke1[i] = kk1[i] * __builtin_amdgcn_exp2f(tot1 - G1);
        *(LAS unsigned*)(sQd + (8 * w + i) * 136 + k0) = qd; *(LAS unsigned*)(sKi + (8 * w + i) * 136 + k0) = ki;
        *(unsigned*)(Q + gbase + (size_t)i * 2048) = qd;
    }
    { v4u a, b, c, d;
      a.x = pk2(ke0[0], ke0[1]); a.y = pk2(ke0[2], ke0[3]); a.z = pk2(ke0[4], ke0[5]); a.w = pk2(ke0[6], ke0[7]);
      b.x = pk2(ke1[0], ke1[1]); b.y = pk2(ke1[2], ke1[3]); b.z = pk2(ke1[4], ke1[5]); b.w = pk2(ke1[6], ke1[7]);
#pragma unroll
      for (int j = 0; j < 4; ++j) { c[j] = (vv[2 * j] & 0xffffu) | (vv[2 * j + 1] << 16); d[j] = (vv[2 * j] >> 16) | (vv[2 * j + 1] & 0xffff0000u); }
      *(LAS v4u*)(sKet + k0 * 72 + 8 * w) = a; *(LAS v4u*)(sKet + (k0 + 1) * 72 + 8 * w) = b;
      *(LAS v4u*)(sVt + k0 * 72 + 8 * w) = c; *(LAS v4u*)(sVt + (k0 + 1) * 72 + 8 * w) = d; }
    if (w == 0) { f32x2 dd; dd.x = __builtin_amdgcn_exp2f(tot0); dd.y = __builtin_amdgcn_exp2f(tot1); *(f32x2*)(Du + k0) = dd; }
    __syncthreads();
#pragma unroll
    for (int tt = 0; tt < 2; ++tt) {
        const int tile = 2 * w + tt, li = tile >> 2, si = tile & 3;
        f32x4 acc = (f32x4){0.f, 0.f, 0.f, 0.f};
        if (si <= li) {
#pragma unroll
            for (int ks = 0; ks < 4; ++ks) { const bf16x8 a = *(const LAS bf16x8*)(sQd + (li * 16 + fr) * 136 + ks * 32 + fq * 8), b = *(const LAS bf16x8*)(sKi + (si * 16 + fr) * 136 + ks * 32 + fq * 8);
                acc = __builtin_amdgcn_mfma_f32_16x16x32_bf16(a, b, acc, 0, 0, 0); }
        }
#pragma unroll
        for (int j = 0; j < 4; ++j) { const int l = li * 16 + fq * 4 + j, s = si * 16 + fr; const float v = (s <= l) ? acc[j] : 0.f; sA[l * 72 + s] = (bf16)f2bf(v); }
    }
    __syncthreads();
    {   const int vi = w;
#pragma unroll
        for (int li = 0; li < 4; ++li) { f32x4 acc = (f32x4){0.f, 0.f, 0.f, 0.f};
#pragma unroll
            for (int ks = 0; ks < 2; ++ks) { const bf16x8 a = *(const LAS bf16x8*)(sVt + (vi * 16 + fr) * 72 + ks * 32 + fq * 8), b = *(const LAS bf16x8*)(sA + (li * 16 + fr) * 72 + ks * 32 + fq * 8);
                acc = __builtin_amdgcn_mfma_f32_16x16x32_bf16(a, b, acc, 0, 0, 0); }
            v2u o; o.x = pk2(acc[0], acc[1]); o.y = pk2(acc[2], acc[3]);
            *(v2u*)(FZ + (size_t)(row0 + li * 16 + fr) * 2048 + h * 128 + vi * 16 + fq * 4) = o; }
#pragma unroll
        for (int ki = 0; ki < 8; ++ki) { f32x4 acc = (f32x4){0.f, 0.f, 0.f, 0.f};
#pragma unroll
            for (int ks = 0; ks < 2; ++ks) { const bf16x8 a = *(const LAS bf16x8*)(sKet + (ki * 16 + fr) * 72 + ks * 32 + fq * 8), b = *(const LAS bf16x8*)(sVt + (vi * 16 + fr) * 72 + ks * 32 + fq * 8);
                acc = __builtin_amdgcn_mfma_f32_16x16x32_bf16(a, b, acc, 0, 0, 0); }
            v2u o; o.x = pk2(acc[0], acc[1]); o.y = pk2(acc[2], acc[3]);
            *(v2u*)(UTu + (size_t)(vi * 16 + fr) * 128 + ki * 16 + fq * 4) = o; }
    }
}
constexpr int H3_Q = 0, H3_S = 17408, H3_SS = 52224;
__device__ __forceinline__ void h3_unit(LAS unsigned char* lds, int row0, int h, const bf16* Q, const bf16* FZ, bf16* OG, const bf16* UTu, const float* hnorm, int) {
    const int tid = opaque_tid(); LAS bf16* sQ = (LAS bf16*)(lds + H3_Q); LAS bf16* sS = (LAS bf16*)(lds + H3_S); LAS float* sSS = (LAS float*)(lds + H3_SS);
    const int lane = tid & 63, w = tid >> 6, fr = lane & 15, fq = lane >> 4;
    { const int r = tid >> 3, sg = tid & 7; const v4u* src = (const v4u*)(Q + (size_t)(row0 + r) * 2048 + h * 128 + sg * 16); const v4u a = src[0], b = src[1];
      const int v = tid >> 2, s4 = tid & 3; const v4u* s2 = (const v4u*)(UTu + (size_t)v * 128 + s4 * 32); const v4u c0 = s2[0], c1 = s2[1], c2 = s2[2], c3 = s2[3];
      *(LAS v4u*)(sQ + r * 136 + sg * 16) = a; *(LAS v4u*)(sQ + r * 136 + sg * 16 + 8) = b;
      *(LAS v4u*)(sS + v * 136 + s4 * 32) = c0; *(LAS v4u*)(sS + v * 136 + s4 * 32 + 8) = c1; *(LAS v4u*)(sS + v * 136 + s4 * 32 + 16) = c2; *(LAS v4u*)(sS + v * 136 + s4 * 32 + 24) = c3; }
    __syncthreads();
    const int vi = w; f32x4 o[4];
#pragma unroll
    for (int li = 0; li < 4; ++li) { f32x4 acc = (f32x4){0.f, 0.f, 0.f, 0.f};
#pragma unroll
        for (int ks = 0; ks < 4; ++ks) { const bf16x8 a = *(const LAS bf16x8*)(sS + (vi * 16 + fr) * 136 + ks * 32 + fq * 8), b = *(const LAS bf16x8*)(sQ + (li * 16 + fr) * 136 + ks * 32 + fq * 8);
            acc = __builtin_amdgcn_mfma_f32_16x16x32_bf16(a, b, acc, 0, 0, 0); }
        const v2u oi = *(const v2u*)(FZ + (size_t)(row0 + li * 16 + fr) * 2048 + h * 128 + vi * 16 + fq * 4);
        acc[0] += bf_lo(oi.x); acc[1] += bf_hi(oi.x); acc[2] += bf_lo(oi.y); acc[3] += bf_hi(oi.y);
        o[li] = acc;
        float ss = (acc[0] * acc[0] + acc[1] * acc[1]) + (acc[2] * acc[2] + acc[3] * acc[3]);
        ss += __shfl_xor(ss, 16); ss += __shfl_xor(ss, 32);
        if (fq == 0) sSS[w * 64 + li * 16 + fr] = ss; }
    __syncthreads();
    const f32x4 hn = *(const f32x4*)(hnorm + h * 128 + vi * 16 + fq * 4);
#pragma unroll
    for (int li = 0; li < 4; ++li) { const int l = li * 16 + fr; float t = 0.f;
#pragma unroll
        for (int j = 0; j < 8; ++j) t += sSS[j * 64 + l];
        const float r = 1.0f / sqrtf(t * (1.0f / 128.0f) + EPS);
        bf16* p = OG + (size_t)(row0 + l) * 2048 + h * 128 + vi * 16 + fq * 4; const v2u sg = *(const v2u*)p;
        v2u y; y.x = pk2(o[li][0] * r * hn.x * bf_lo(sg.x), o[li][1] * r * hn.y * bf_hi(sg.x)); y.y = pk2(o[li][2] * r * hn.z * bf_lo(sg.y), o[li][3] * r * hn.w * bf_hi(sg.y));
        *(v2u*)p = y; }
}
__device__ __forceinline__ void scan_prompt(bf16* UT, const float* D, float* out_state  , int gbase, int gthreads) {
    const int gtid = gbase + opaque_tid();
    for (int e = gtid; e < 16 * 128 * 16; e += gthreads) {
        const int h = e >> 11, rem = e & 2047, v = rem >> 4, k = 8 * (rem & 15);
        bf16* up = UT + (size_t)h * 16384 + v * 128 + k; const float* dp = D + h * 128 + k;
        float s[8];
#pragma unroll
        for (int j = 0; j < 8; ++j) s[j] = 0.f;
        for (int c0 = 0; c0 < 256; c0 += 8) {
            v4u u[8]; f32x4 d0[8], d1[8];
#pragma unroll
            for (int i = 0; i < 8; ++i) { u[i] = *(const v4u*)(up + (size_t)(c0 + i) * 16 * 16384); d0[i] = *(const f32x4*)(dp + (size_t)(c0 + i) * 16 * 128); d1[i] = *(const f32x4*)(dp + (size_t)(c0 + i) * 16 * 128 + 4); }
#pragma unroll
            for (int i = 0; i < 8; ++i) {
                v4u o; o.x = pk2(s[0], s[1]); o.y = pk2(s[2], s[3]); o.z = pk2(s[4], s[5]); o.w = pk2(s[6], s[7]);
                *(v4u*)(up + (size_t)(c0 + i) * 16 * 16384) = o;
                s[0] = d0[i].x * s[0] + bf_lo(u[i].x); s[1] = d0[i].y * s[1] + bf_hi(u[i].x); s[2] = d0[i].z * s[2] + bf_lo(u[i].y); s[3] = d0[i].w * s[3] + bf_hi(u[i].y);
                s[4] = d1[i].x * s[4] + bf_lo(u[i].z); s[5] = d1[i].y * s[5] + bf_hi(u[i].z); s[6] = d1[i].z * s[6] + bf_lo(u[i].w); s[7] = d1[i].w * s[7] + bf_hi(u[i].w);
            }
        }
#pragma unroll
        for (int j = 0; j < 8; ++j) out_state[((size_t)h * 128 + k + j) * 128 + v] = s[j];
    }
}
__device__ __forceinline__ void scan_sample(bf16* UT  , const float* D, const float* st_in, float* st_out, int gbase, int gthreads) {
    const int gtid = gbase + opaque_tid();
    for (int e = gtid; e < 16 * 16 * 128 * 16; e += gthreads) {
        const int bh = e >> 11, rem = e & 2047, v = rem >> 4, k = 8 * (rem & 15);
        bf16* up = UT + (size_t)bh * 16384 + v * 128 + k; const f32x4 d0 = *(const f32x4*)(D + bh * 128 + k), d1 = *(const f32x4*)(D + bh * 128 + k + 4);
        const size_t si = ((size_t)bh * 128 + k) * 128 + v;
        float a[8];
#pragma unroll
        for (int j = 0; j < 8; ++j) a[j] = st_in[si + (size_t)j * 128];
        const v4u u = *(const v4u*)up;
        v4u o; o.x = pk2(a[0], a[1]); o.y = pk2(a[2], a[3]); o.z = pk2(a[4], a[5]); o.w = pk2(a[6], a[7]);
        *(v4u*)up = o;
        st_out[si] = d0.x * a[0] + bf_lo(u.x); st_out[si + 128] = d0.y * a[1] + bf_hi(u.x); st_out[si + 256] = d0.z * a[2] + bf_lo(u.y); st_out[si + 384] = d0.w * a[3] + bf_hi(u.y);
        st_out[si + 512] = d1.x * a[4] + bf_lo(u.z); st_out[si + 640] = d1.y * a[5] + bf_hi(u.z); st_out[si + 768] = d1.z * a[6] + bf_lo(u.w); st_out[si + 896] = d1.w * a[7] + bf_hi(u.w);
    }
}

#define RLX_AGENT __ATOMIC_RELAXED, __HIP_MEMORY_SCOPE_AGENT
#define XB_TMO      128
#define XB_XCNT(j)  (256  + 64 * (j))
#define XB_XSUB(j)  (1280 + 64 * (j))
#define XB_XGEN(j)  (2304 + 64 * (j))
#define XB_TOP      3328
#define XB_TOPGEN   3392
#define XCD_BAR_WORDS 3456
#define XB_SPIN_CAP (1u << 18)

__device__ __forceinline__ unsigned xb_ld(unsigned* p)              { return __hip_atomic_load(p, __ATOMIC_RELAXED, __HIP_MEMORY_SCOPE_AGENT); }
__device__ __forceinline__ unsigned xb_add(unsigned* p, unsigned v) { return __hip_atomic_fetch_add(p, v, __ATOMIC_RELAXED, __HIP_MEMORY_SCOPE_AGENT); }
__device__ __forceinline__ unsigned xb_xcc_id() { return (unsigned)__builtin_amdgcn_s_getreg((3 << 11) | 20) & 0xFu; }
#define XB_SPIN(cond, bar) do { unsigned _sp = 0; while (cond) { __builtin_amdgcn_s_sleep(1); \
    if ((++_sp & 255u) == 0u) { if (xb_ld(&(bar)[XB_TMO])) break; if (_sp > XB_SPIN_CAP) { atomicAdd(&(bar)[XB_TMO], 1u); break; } } } } while (0)

struct XcdBarrier {
    unsigned* bar; unsigned x;
    volatile LAS unsigned* st;
};

__device__ __forceinline__ XcdBarrier xcd_barrier_post(unsigned* bar, volatile LAS unsigned* st) {
    XcdBarrier b; b.bar = bar; b.x = xb_xcc_id(); b.st = st;
    if (threadIdx.x == 0) (void)xb_add(&bar[XB_XCNT(b.x)], 1u);
    return b;
}
__device__ __forceinline__ void xcd_barrier_complete(unsigned* bar, unsigned x, unsigned& nloc, unsigned& nx) {
    const unsigned G = gridDim.x * gridDim.y * gridDim.z;
    unsigned sum, cnt, mine, sp = 0u;
    for (;;) {
        sum = 0u; cnt = 0u; mine = 0u;
#pragma unroll
        for (unsigned j = 0; j < 16; ++j) { const unsigned c = xb_ld(&bar[XB_XCNT(j)]); sum += c; cnt += (c > 0u) ? 1u : 0u; mine = (j == x) ? c : mine; }
        if (sum == G) break;
        __builtin_amdgcn_s_sleep(1);
        if ((++sp & 255u) == 0u) { if (xb_ld(&bar[XB_TMO])) break; if (sp > XB_SPIN_CAP) { atomicAdd(&bar[XB_TMO], 1u); break; } }
    }
    nloc = mine > 0u ? mine : 1u; nx = cnt > 0u ? cnt : 1u;
}

__device__ __forceinline__ void xcd_barrier(const XcdBarrier& b) {
    asm volatile("s_waitcnt vmcnt(0)" ::: "memory");
    __syncthreads();
    if (threadIdx.x == 0) {
        unsigned* bar = b.bar;
        __builtin_amdgcn_s_waitcnt(0);
        unsigned nloc = b.st[0], nx = b.st[1];
        if (nloc == 0u) { xcd_barrier_complete(bar, b.x, nloc, nx); b.st[0] = nloc; b.st[1] = nx; }
        const unsigned old = xb_add(&bar[XB_XSUB(b.x)], 1u);
        const unsigned gen = old / nloc;
        if (old + 1u == (gen + 1u) * nloc) {
            __builtin_amdgcn_fence(__ATOMIC_RELEASE, "agent");
            asm volatile("s_waitcnt vmcnt(0)" ::: "memory");
            const unsigned og = xb_add(&bar[XB_TOP], 1u);
            const unsigned tg = og / nx;
            if (og + 1u == (tg + 1u) * nx) xb_add(&bar[XB_TOPGEN], 1u);
            else XB_SPIN(xb_ld(&bar[XB_TOPGEN]) == tg, bar);
            __builtin_amdgcn_fence(__ATOMIC_ACQUIRE, "agent");
            xb_add(&bar[XB_XGEN(b.x)], 1u);
            asm volatile("s_waitcnt vmcnt(0)" ::: "memory");
        } else {
            XB_SPIN(xb_ld(&bar[XB_XGEN(b.x)]) == gen, bar);
            __builtin_amdgcn_fence(__ATOMIC_ACQUIRE, "agent");
            asm volatile("s_waitcnt vmcnt(0)" ::: "memory");
        }
    }
    __syncthreads();
}

__device__ __forceinline__ int tid_k() { return threadIdx.x; }
__device__ __forceinline__ LAS unsigned char* lds_raw_las(unsigned char* p) { return (LAS unsigned char*)p; }
struct Args { const float* in[21]; float* out; unsigned char* ws; };
__global__ void __launch_bounds__(512, 2) mk_fwd(Args a) {
    extern __shared__ __attribute__((aligned(16))) unsigned char lds_raw[];
    cg::grid_group grid = cg::this_grid();
    for (int u = tid_k(); u < 256; u += 512) ((LAS unsigned*)(lds_raw_las(lds_raw) + 131072))[u] = 0u;
    __syncthreads();
    XcdBarrier bar = xcd_barrier_post((unsigned*)a.ws, (volatile LAS unsigned*)(lds_raw_las(lds_raw) + 131072));
    asm volatile("s_waitcnt vmcnt(0) lgkmcnt(0)" ::: "memory"); grid.sync();
#define GRID_SYNC() xcd_barrier(bar)
    LAS unsigned char* lds = (LAS unsigned char*)lds_raw;
    const int tid = threadIdx.x, lane = tid & 63, wave = __builtin_amdgcn_readfirstlane(tid >> 6);
    const int G = gridDim.x, bx = blockIdx.x;
    const int vcu = (G % 8 == 0) ? (bx % 8) * (G / 8) + bx / 8 : bx;
    const int gw = vcu * 8 + wave, NGW = G * 8;
    unsigned char* ws = a.ws; float* out = a.out;
    bf16* W1GU = (bf16*)(ws + WS_W1GU); bf16* W1D = (bf16*)(ws + WS_W1D); bf16* WIN = (bf16*)(ws + WS_WIN); bf16* WBC = (bf16*)(ws + WS_WBC); bf16* WBH = (bf16*)(ws + WS_WBH);
    bf16* WOUT = (bf16*)(ws + WS_WOUT); bf16* W2GU = (bf16*)(ws + WS_W2GU); bf16* W2D = (bf16*)(ws + WS_W2D);
    bf16* XN = (bf16*)(ws + WS_XN); bf16* HB = (bf16*)(ws + WS_H);
    bf16* GB = (bf16*)(ws + WS_GB); bf16* GC = (bf16*)(ws + WS_GC); bf16* VC = (bf16*)(ws + WS_VC); bf16* QB = (bf16*)(ws + WS_Q); bf16* FZ = (bf16*)(ws + WS_FZ); bf16* IV = (bf16*)(ws + WS_IV);
    bf16* OG = (bf16*)(ws + WS_OG); bf16* SGC = (bf16*)(ws + WS_SGC); bf16* SGH = (bf16*)(ws + WS_SGH); bf16* UT = (bf16*)(ws + WS_UT); float* DD = (float*)(ws + WS_D);
    bf16* XS = (bf16*)(ws + 720 * MiB);
    constexpr int KSPLIT = 4;
    bf16* MG = QB;

    {
        LAS float* scr = (LAS float*)(lds + wave * 16384);
        constexpr int I_F = (DM / 64) * (DFF / 32), I_D = (DFF / 64) * (DM / 32), I_IN = (DM / 64) * (DIN / 32), I_BC = (DCV / 64) * (DM / 32), I_SQ = (DM / 64) * (DM / 32);
        constexpr int NITEMS = 4 * I_F + 2 * I_D + I_IN + I_BC + 2 * I_SQ;
        for (int it = gw; it < NITEMS; it += NGW) {
            int r = it;
            if (r < I_F) { transpose_item(a.in[5], DM, DFF, W1GU, 1, scr, r, lane); continue; } r -= I_F;
            if (r < I_F) { transpose_item(a.in[6], DM, DFF, W1GU, 2, scr, r, lane); continue; } r -= I_F;
            if (r < I_D) { transpose_item(a.in[7], DFF, DM, W1D, 0, scr, r, lane); continue; } r -= I_D;
            if (r < I_IN) { transpose_item(a.in[9], DM, DIN, WIN, 0, scr, r, lane); continue; } r -= I_IN;
            if (r < I_BC) { transpose_item(a.in[13], DCV, DM, WBC, 0, scr, r, lane); continue; } r -= I_BC;
            if (r < I_SQ) { transpose_item(a.in[14], DH, DM, WBH, 0, scr, r, lane); continue; } r -= I_SQ;
            if (r < I_SQ) { transpose_item(a.in[15], DM, DM, WOUT, 0, scr, r, lane); continue; } r -= I_SQ;
            if (r < I_F) { transpose_item(a.in[17], DM, DFF, W2GU, 1, scr, r, lane); continue; } r -= I_F;
            if (r < I_F) { transpose_item(a.in[18], DM, DFF, W2GU, 2, scr, r, lane); continue; } r -= I_F;
            transpose_item(a.in[19], DFF, DM, W2D, 0, scr, r, lane);
        }
        rms_rows_bf16(a.in[0], a.in[1], a.in[4], XN, 0, TT, gw, NGW, lane);
    }
    GRID_SYNC();
    { pg8::Gemm g{XN, W1GU, TT, 2 * DFF, DM}; pg8::StaticOrder S; S.init(TT, 2 * DFF, G, bx, DM / 64); pg8::EpiSwiGLU E{HB, DFF};
      pg8::gemm_phase<pg8::EpiSwiGLU, pg8::StaticOrder, PG8_ALIGN, PG8_SP2>(lds, g, S, E); }
    GRID_SYNC();
    { pg8::Gemm g{HB, W1D, TT, DM, DFF}; pg8::StaticOrder S; S.init(TT, DM, G, bx, DFF / 64, KSPLIT); pg8::EpiDelta E{XN, DM, 0.5f, XS, KSPLIT - 1};
      pg8::gemm_phase<pg8::EpiDelta, pg8::StaticOrder, PG8_ALIGN, PG8_SP2>(lds, g, S, E); }
    GRID_SYNC();
    build_split_table(lds + 4096, G, KSPLIT);
    rms_rows_delta_bf16(a.in[0], a.in[1], a.in[8], XN, out, gw, NGW, XS, KSPLIT - 1, lds + 4096);
    GRID_SYNC();
    for (int grp = 0; grp < 2; ++grp) {
        const int tok0 = grp ? SEQ : 0, Tg = grp ? (SEQ + TS) : SEQ, nch = Tg / 64;
        { pg8::Gemm g{XN + (size_t)tok0 * DM, WIN, Tg, DIN, DM}; pg8::StaticOrder S; S.init(Tg, DIN, G, bx, DM / 64); pg8::EpiProj E{GB, GC, VC, QB, FZ, IV, OG, SGC, SGH};
          pg8::gemm_phase<pg8::EpiProj, pg8::StaticOrder, PG8_ALIGN, PG8_SP2>(lds, g, S, E); }
        GRID_SYNC();
        for (int cl = vcu; cl < nch; cl += G) {
            const bool smp = cl >= 256; const int bs = cl - 256;
            const float* hist = smp ? a.in[2] + (size_t)bs * 2048 : nullptr;
            float* newc = smp ? out + O_NCS + (size_t)bs * 2048 : out + O_NCP + (size_t)grp * 2048;
            conv_item(cl, smp || cl == 0, smp || cl == 255, hist, newc, GB, GC, VC, a.in[10], tid);
        }
        for (int ul = vcu; ul < nch * 16; ul += G) {
            const int cl = ul >> 4, h = ul & 15;
            h1_unit(lds, cl * 64, h, QB, FZ, IV, UT + (size_t)ul * 16384, DD + (size_t)ul * 128, a.in[11], tid);
        }
        GRID_SYNC();
        scan_prompt(UT, DD, out + O_NHP + (size_t)grp * 16 * 16384, vcu * 512, G * 512);
        if (grp) scan_sample(UT + (size_t)256 * 16 * 16384, DD + (size_t)256 * 16 * 128, a.in[3], out + O_NHS, vcu * 512, G * 512);
        GRID_SYNC();
        for (int ul = vcu; ul < nch * 16; ul += G) {
            const int cl = ul >> 4, h = ul & 15;
            h3_unit(lds, cl * 64, h, QB, FZ, OG, UT + (size_t)ul * 16384, a.in[12], tid);
        }
        GRID_SYNC();
        { pg8::StaticOrder S;
          { S.init(Tg, DM, G, bx, DCV / 64); pg8::Gemm g{GB, WBC, Tg, DM, DCV}; pg8::EpiMerge<false> E{SGC, MG}; pg8::gemm_phase<pg8::EpiMerge<false>, pg8::StaticOrder, PG8_ALIGN, PG8_SP2>(lds, g, S, E); }
          { S.init(Tg, DM, G, bx, DH / 64); pg8::Gemm g{OG, WBH, Tg, DM, DH}; pg8::EpiMerge<true> E{SGH, MG}; pg8::gemm_phase<pg8::EpiMerge<true>, pg8::StaticOrder, PG8_ALIGN, PG8_SP2>(lds, g, S, E); } }
        GRID_SYNC();
        { float* xo = out + (size_t)tok0 * DM; pg8::Gemm g{MG, WOUT, Tg, DM, DM}; pg8::StaticOrder S; S.init(Tg, DM, G, bx, DM / 64); pg8::EpiDelta E{XN + (size_t)tok0 * DM, DM, 1.0f, nullptr, 0};
          (void)xo; pg8::gemm_phase<pg8::EpiDelta, pg8::StaticOrder, PG8_ALIGN, PG8_SP2>(lds, g, S, E); }
        GRID_SYNC();
    }
    rms_rows_delta_bf16(out, out + (size_t)TP * DM, a.in[16], XN, out, gw, NGW);
    GRID_SYNC();
    { pg8::Gemm g{XN, W2GU, TT, 2 * DFF, DM}; pg8::StaticOrder S; S.init(TT, 2 * DFF, G, bx, DM / 64); pg8::EpiSwiGLU E{HB, DFF};
      pg8::gemm_phase<pg8::EpiSwiGLU, pg8::StaticOrder, PG8_ALIGN, PG8_SP2>(lds, g, S, E); }
    GRID_SYNC();
    { pg8::Gemm g{HB, W2D, TT, DM, DFF}; pg8::StaticOrder S; S.init(TT, DM, G, bx, DFF / 64, KSPLIT); pg8::EpiDelta E{XN, DM, 0.5f, XS, KSPLIT - 1};
      pg8::gemm_phase<pg8::EpiDelta, pg8::StaticOrder, PG8_ALIGN, PG8_SP2>(lds, g, S, E); }
    GRID_SYNC();
    build_split_table(lds + 4096, G, KSPLIT);
    rms_rows_delta_final(out, XN, a.in[20], gw, NGW, XS, KSPLIT - 1, lds + 4096);
}

extern "C" void kernel_launch(void* const* d_in, const int* in_sizes, int n_in, void* d_out, int out_size, void* d_ws, size_t ws_size, hipStream_t stream) {
    static int grid = 0;
    if (grid == 0) {
        if (n_in != 21 || ws_size < WS_END) { fprintf(stderr, "kernel_launch: unexpected n_in %d / ws_size %zu (need %zu)\n", n_in, ws_size, (size_t)WS_END); grid = -1; return; }
        int dev = 0, cus = 0, per_cu = 0;
        hipGetDevice(&dev); hipDeviceGetAttribute(&cus, hipDeviceAttributeMultiprocessorCount, dev);
        if (hipFuncSetAttribute((const void*)mk_fwd, hipFuncAttributeMaxDynamicSharedMemorySize, LDS_BYTES) != hipSuccess) { fprintf(stderr, "kernel_launch: hipFuncSetAttribute failed\n"); grid = -1; return; }
        if (hipOccupancyMaxActiveBlocksPerMultiprocessor(&per_cu, (const void*)mk_fwd, 512, LDS_BYTES) != hipSuccess || per_cu < 1) { fprintf(stderr, "kernel_launch: occupancy query says %d\n", per_cu); per_cu = 1; }
        (void)hipGetLastError();
        grid = cus * 1;
        (void)per_cu;
    }
    if (grid < 0) return;
    if (hipMemsetAsync(d_ws, 0, 16384, stream) != hipSuccess) { fprintf(stderr, "kernel_launch: hipMemsetAsync failed\n"); return; }
    Args a{};
    for (int i = 0; i < 21; ++i) a.in[i] = (const float*)d_in[i];
    a.out = (float*)d_out; a.ws = (unsigned char*)d_ws;
    void* args[] = {&a};
    hipError_t e = hipLaunchCooperativeKernel((const void*)mk_fwd, dim3(grid), dim3(512), args, LDS_BYTES, stream);
    if (e != hipSuccess) fprintf(stderr, "kernel_launch: cooperative launch failed: %s (grid %d)\n", hipGetErrorString(e), grid);
}
```

```cpp
#include <hip/hip_runtime.h>
#include <hip/hip_cooperative_groups.h>
#include <cstdio>
#include <cstdint>
namespace cg = cooperative_groups;
namespace pg8 {
#define PG8_LAS __attribute__((address_space(3)))
typedef unsigned short bf16_t;
typedef short bf16x8 __attribute__((ext_vector_type(8)));
typedef float f32x4 __attribute__((ext_vector_type(4)));
typedef unsigned u32x4 __attribute__((ext_vector_type(4)));
constexpr int BM = 256, BK = 64, HALF = 128, HTB = HALF * BK * 2  , STAGE_BYTES = 8 * HTB, NXCD = 8, WGM = 8;

__host__ __device__ __forceinline__ int lds_byte(int r, int c) { const int st = (r >> 4) * 2 + (c >> 5), rr = r & 15, cc = c & 31, ob = rr * 64 + cc * 2; return st * 1024 + (ob ^ (((ob >> 9) & 1) << 5)); }
__host__ __device__ __forceinline__ void stage_rc(int b, int& R, int& C) { const int st = b / 1024, sb = b % 1024, swz = sb ^ (((sb >> 9) & 1) << 5); R = (st >> 1) * 16 + swz / 64; C = (st & 1) * 32 + (swz % 64) / 2; }
__host__ __device__ __forceinline__ int perm32(int rho) { const int n = rho >> 4, i = rho & 15; return 8 * (i >> 2) + 4 * n + (i & 3); }

struct Unit { int pm, pn; };
struct Gemm { const bf16_t* A; const bf16_t* Bt; int M, N, K; };

struct StaticOrder {
    int nM, nN, nwg, G, c;
    __host__ __device__ void init(int M, int N, int G_, int c_) { nM = M / BM; nN = N / BM; nwg = nM * nN; G = G_; c = c_; }
    __host__ __device__ bool next(int i, Unit& u) const {
        const long L = (long)i * G + c; if (L >= nwg) return false;
        int wgid = (int)L; { const int q = nwg / NXCD, r = nwg % NXCD, xcd = wgid % NXCD, off = wgid / NXCD; wgid = (xcd < r ? xcd * (q + 1) : r * (q + 1) + (xcd - r) * q) + off; }
        const int nig = WGM * nN, gid = wgid / nig, fm = gid * WGM, gsz = (nM - fm) < WGM ? (nM - fm) : WGM;
        u.pm = fm + ((wgid % nig) % gsz); u.pn = (wgid % nig) / gsz; return true;
    }
    __device__ __forceinline__ void a_ready(const Unit&) const {}
    __device__ __forceinline__ void done(const Unit&) const {}
};

typedef __bf16 bf16v2_t __attribute__((ext_vector_type(2))); typedef float f32v2_t __attribute__((ext_vector_type(2)));
__device__ __forceinline__ unsigned cvt_pk_bf16(float lo, float hi) { const f32v2_t v = {lo, hi}; return __builtin_bit_cast(unsigned, __builtin_convertvector(v, bf16v2_t)); }
__device__ __forceinline__ float rnd_m5(float x) { unsigned u = __builtin_bit_cast(unsigned, x); u = (u + 0x1ffffu + ((u >> 18) & 1u)) & 0xfffc0000u; return __builtin_bit_cast(float, u); }
__device__ __forceinline__ float bf_lo(unsigned u) { return __uint_as_float(u << 16); }
__device__ __forceinline__ float bf_hi(unsigned u) { return __uint_as_float(u & 0xffff0000u); }
__device__ __forceinline__ float fast_sigmoid(float x) { return __builtin_amdgcn_rcpf(1.0f + __builtin_amdgcn_exp2f(-1.44269504f * x)); }
__device__ __forceinline__ float fast_silu(float x) { return x * fast_sigmoid(x); }
typedef unsigned u32x2 __attribute__((ext_vector_type(2)));

struct EpiSwiGLU {
    static constexpr bool PERM = true, AFTER_DRAIN = false;
    bf16_t* H; int ldh;
    __device__ __forceinline__ void operator()(const f32x4 (&acc)[2][2][4][2], const Unit& u, int wr, int wc, int fr, int fq) const {
        const int row0 = u.pm * BM + wr * 64 + fr, col0 = u.pn * HALF + wc * 32 + 8 * fq;
#pragma unroll
        for (int ai = 0; ai < 2; ++ai)
#pragma unroll
            for (int m = 0; m < 4; ++m) {
                bf16_t* rowp = H + (size_t)(row0 + ai * HALF + m * 16) * ldh + col0;
                float h[8];
#pragma unroll
                for (int n = 0; n < 2; ++n)
#pragma unroll
                    for (int j = 0; j < 4; ++j) h[n * 4 + j] = rnd_m5(fast_silu(acc[ai][0][m][n][j]) * acc[ai][1][m][n][j]);
                u32x4 w; w.x = cvt_pk_bf16(h[0], h[1]); w.y = cvt_pk_bf16(h[2], h[3]); w.z = cvt_pk_bf16(h[4], h[5]); w.w = cvt_pk_bf16(h[6], h[7]);
                *(u32x4*)rowp = w;
            }
    }
};
struct EpiRes {
    static constexpr bool PERM = false, AFTER_DRAIN = false;
    const float* base0; const float* base1; int split; float* out; int ldc; float scale;
    __device__ __forceinline__ void operator()(const f32x4 (&acc)[2][2][4][2], const Unit& u, int wr, int wc, int fr, int fq) const {
        const int row0 = u.pm * BM + wr * 64 + fr, col0 = u.pn * BM + wc * 32 + 4 * fq;
        const float* bs = (u.pm * BM < split) ? base0 : base1 - (size_t)split * ldc;
#pragma unroll
        for (int ai = 0; ai < 2; ++ai) {
            f32x4 b[4][2][2];
#pragma unroll
            for (int m = 0; m < 4; ++m) { const size_t off = (size_t)(row0 + ai * HALF + m * 16) * ldc + col0;
#pragma unroll
                for (int bj = 0; bj < 2; ++bj)
#pragma unroll
                    for (int n = 0; n < 2; ++n) b[m][bj][n] = *(const f32x4*)(bs + off + bj * HALF + n * 16); }
#pragma unroll
            for (int m = 0; m < 4; ++m) { const size_t off = (size_t)(row0 + ai * HALF + m * 16) * ldc + col0;
#pragma unroll
                for (int bj = 0; bj < 2; ++bj)
#pragma unroll
                    for (int n = 0; n < 2; ++n) *(f32x4*)(out + off + bj * HALF + n * 16) = b[m][bj][n] + acc[ai][bj][m][n] * scale; }
            asm volatile("" ::: "memory");
        }
    }
};
struct EpiDelta {
    static constexpr bool PERM = true, AFTER_DRAIN = false;
    bf16_t* D; int ldc; float scale;
    __device__ __forceinline__ void operator()(const f32x4 (&acc)[2][2][4][2], const Unit& u, int wr, int wc, int fr, int fq) const {
        const int row0 = u.pm * BM + wr * 64 + fr, col0 = u.pn * BM + wc * 32 + 8 * fq;
#pragma unroll
        for (int ai = 0; ai < 2; ++ai)
#pragma unroll
            for (int m = 0; m < 4; ++m) { bf16_t* rowp = D + (size_t)(row0 + ai * HALF + m * 16) * ldc + col0;
#pragma unroll
                for (int bj = 0; bj < 2; ++bj) { const f32x4 v0 = acc[ai][bj][m][0] * scale, v1 = acc[ai][bj][m][1] * scale;
                    u32x4 w; w.x = cvt_pk_bf16(v0[0], v0[1]); w.y = cvt_pk_bf16(v0[2], v0[3]); w.z = cvt_pk_bf16(v1[0], v1[1]); w.w = cvt_pk_bf16(v1[2], v1[3]);
                    *(u32x4*)(rowp + bj * HALF) = w; } }
    }
};
struct EpiProj {
    static constexpr bool PERM = true, AFTER_DRAIN = false;
    bf16_t *GB, *GC, *VC, *Q, *FZ, *IV, *OG, *SGC, *SGH;
    __device__ __forceinline__ void operator()(const f32x4 (&acc)[2][2][4][2], const Unit& u, int wr, int wc, int fr, int fq) const {
        const int pn = u.pn; bf16_t* base; int ldc, colt, act;
        if (pn < 4) { base = GB; ldc = 1024; colt = pn * 256; act = 0; }
        else if (pn < 8) { base = GC; ldc = 1024; colt = (pn - 4) * 256; act = 0; }
        else if (pn < 12) { base = VC; ldc = 1024; colt = (pn - 8) * 256; act = 0; }
        else if (pn < 20) { base = Q; ldc = 2048; colt = (pn - 12) * 256; act = 1; }
        else if (pn < 28) { base = FZ; ldc = 2048; colt = (pn - 20) * 256; act = 0; }
        else if (pn < 36) { base = IV; ldc = 2048; colt = (pn - 28) * 256; act = 0; }
        else if (pn < 44) { base = OG; ldc = 2048; colt = (pn - 36) * 256; act = 1; }
        else if (pn < 52) { base = SGC; ldc = 2048; colt = (pn - 44) * 256; act = 2; }
        else { base = SGH; ldc = 2048; colt = (pn - 52) * 256; act = 2; }
        const int row0 = u.pm * BM + wr * 64 + fr, col0 = colt + wc * 32 + 8 * fq;
#pragma unroll
        for (int ai = 0; ai < 2; ++ai)
#pragma unroll
            for (int m = 0; m < 4; ++m) { bf16_t* rowp = base + (size_t)(row0 + ai * HALF + m * 16) * ldc + col0;
#pragma unroll
                for (int bj = 0; bj < 2; ++bj) { float v[8];
#pragma unroll
                    for (int n = 0; n < 2; ++n)
#pragma unroll
                        for (int j = 0; j < 4; ++j) { const float x = acc[ai][bj][m][n][j]; v[n * 4 + j] = (act == 0) ? x : (act == 1 ? fast_silu(x) : fast_sigmoid(x)); }
                    u32x4 w; w.x = cvt_pk_bf16(v[0], v[1]); w.y = cvt_pk_bf16(v[2], v[3]); w.z = cvt_pk_bf16(v[4], v[5]); w.w = cvt_pk_bf16(v[6], v[7]);
                    *(u32x4*)(rowp + bj * HALF) = w; } }
    }
};
template <bool ACCUM> struct EpiMerge {
    static constexpr bool PERM = true, AFTER_DRAIN = false;
    const bf16_t* G; bf16_t* O;
    __device__ __forceinline__ void operator()(const f32x4 (&acc)[2][2][4][2], const Unit& u, int wr, int wc, int fr, int fq) const {
        const int row0 = u.pm * BM + wr * 64 + fr, col0 = u.pn * BM + wc * 32 + 8 * fq;
#pragma unroll
        for (int ai = 0; ai < 2; ++ai)
#pragma unroll
            for (int m = 0; m < 4; ++m) { const size_t off = (size_t)(row0 + ai * HALF + m * 16) * 2048 + col0;
#pragma unroll
                for (int bj = 0; bj < 2; ++bj) { const u32x4 g = *(const u32x4*)(G + off + bj * HALF); float v[8];
                    v[0] = bf_lo(g.x) * acc[ai][bj][m][0][0]; v[1] = bf_hi(g.x) * acc[ai][bj][m][0][1]; v[2] = bf_lo(g.y) * acc[ai][bj][m][0][2]; v[3] = bf_hi(g.y) * acc[ai][bj][m][0][3];
                    v[4] = bf_lo(g.z) * acc[ai][bj][m][1][0]; v[5] = bf_hi(g.z) * acc[ai][bj][m][1][1]; v[6] = bf_lo(g.w) * acc[ai][bj][m][1][2]; v[7] = bf_hi(g.w) * acc[ai][bj][m][1][3];
                    if (ACCUM) { const u32x4 p = *(const u32x4*)(O + off + bj * HALF);
                        v[0] += bf_lo(p.x); v[1] += bf_hi(p.x); v[2] += bf_lo(p.y); v[3] += bf_hi(p.y); v[4] += bf_lo(p.z); v[5] += bf_hi(p.z); v[6] += bf_lo(p.w); v[7] += bf_hi(p.w); }
                    u32x4 w; w.x = cvt_pk_bf16(v[0], v[1]); w.y = cvt_pk_bf16(v[2], v[3]); w.z = cvt_pk_bf16(v[4], v[5]); w.w = cvt_pk_bf16(v[6], v[7]);
                    *(u32x4*)(O + off + bj * HALF) = w; } }
    }
};
template <class Epi, class Sched, bool ALIGN_EPI = false, bool SP2 = false>
__device__ __forceinline__ void gemm_phase(PG8_LAS unsigned char* lds, const Gemm g, const Sched& S, const Epi& E) {
    int tid_ = threadIdx.x; asm volatile("" : "+v"(tid_));
    const int tid = tid_, wid = __builtin_amdgcn_readfirstlane(tid >> 6), lane = tid & 63, wr = wid >> 2, wc = wid & 3, fr = lane & 15, fq = lane >> 4;
    const int K = g.K, nt = K / BK;
    unsigned voffA[2], voffB[2];
#pragma unroll
    for (int i = 0; i < 2; ++i) { int R, C; stage_rc(tid * 16 + i * 8192, R, C); const int Rb = Epi::PERM ? ((R & ~31) + perm32(R & 31)) : R;
        voffA[i] = (unsigned)(R * K + C) * 2u; voffB[i] = (unsigned)(Rb * K + C) * 2u; }
    const size_t kstep = (size_t)(BK * 2);
    const size_t hstep = (size_t)HALF * K * 2;
    const size_t tstep = 2 * hstep;
    const unsigned ldsw = (unsigned)wid * 1024u;
    const int aoff = lds_byte(wr * 64 + fr, fq * 8), boff = lds_byte(wc * 32 + fr, fq * 8);
#define PG8_SA(b, h) (((b) * 2 + (h)) * HTB)
#define PG8_SB(b, h) ((4 + (b) * 2 + (h)) * HTB)
#define PG8_STAGE(bufoff, gbase, voff) do { _Pragma("unroll") for (int _i = 0; _i < 2; ++_i) \
        __builtin_amdgcn_global_load_lds((const unsigned*)((const char*)(gbase) + (voff)[_i]), (PG8_LAS unsigned*)(lds + (bufoff) + ldsw + _i * 8192), 16, 0, 0); } while (0)
#define PG8_LDA(dst, b, h) do { _Pragma("unroll") for (int m = 0; m < 4; ++m) _Pragma("unroll") for (int k = 0; k < 2; ++k) dst[m][k] = *(const PG8_LAS bf16x8*)(lds + PG8_SA(b, h) + aoff + m * 2048 + k * 1024); } while (0)
#define PG8_LDB(dst, b, h) do { _Pragma("unroll") for (int n = 0; n < 2; ++n) _Pragma("unroll") for (int k = 0; k < 2; ++k) dst[n][k] = *(const PG8_LAS bf16x8*)(lds + PG8_SB(b, h) + boff + n * 2048 + k * 1024); } while (0)
#define PG8_MMA(ai, bj, At, Bt) do { __builtin_amdgcn_s_setprio(1); _Pragma("unroll") for (int m = 0; m < 4; ++m) _Pragma("unroll") for (int n = 0; n < 2; ++n) _Pragma("unroll") for (int k = 0; k < 2; ++k) \
        acc[ai][bj][m][n] = __builtin_amdgcn_mfma_f32_16x16x32_bf16(Bt[n][k], At[m][k], acc[ai][bj][m][n], 0, 0, 0); __builtin_amdgcn_s_setprio(0); } while (0)
#define PG8_WAIT_V(n) asm volatile("s_waitcnt vmcnt(" #n ")" ::: "memory")
#define PG8_WAIT_L(n) asm volatile("s_waitcnt lgkmcnt(" #n ")" ::: "memory")
#define PG8_BAR __builtin_amdgcn_s_barrier()
#define PG8_SCHED __builtin_amdgcn_sched_barrier(0)
    Unit cur, nxt; int ui = 0;
    if (!S.next(0, cur)) return;
    f32x4 acc[2][2][4][2];
#pragma unroll
    for (int a = 0; a < 2; ++a)
#pragma unroll
        for (int b = 0; b < 2; ++b)
#pragma unroll
            for (int m = 0; m < 4; ++m)
#pragma unroll
                for (int n = 0; n < 2; ++n) acc[a][b][m][n] = (f32x4){0.f, 0.f, 0.f, 0.f};
    bf16x8 At[4][2], B0[2][2], B1[2][2];
    const char* cA = (const char*)g.A + (size_t)cur.pm * tstep; const char* cB = (const char*)g.Bt + (size_t)cur.pn * tstep;
    S.a_ready(cur);
    if constexpr (SP2) {
        PG8_STAGE(PG8_SB(0, 0), cB, voffB); PG8_STAGE(PG8_SB(0, 1), cB + hstep, voffB); PG8_STAGE(PG8_SA(0, 0), cA, voffA); PG8_STAGE(PG8_SA(0, 1), cA + hstep, voffA);
        if (wr == 1) PG8_BAR;
        PG8_WAIT_V(2); PG8_BAR;
        PG8_STAGE(PG8_SB(1, 0), cB + kstep, voffB); PG8_STAGE(PG8_SA(1, 0), cA + kstep, voffA); PG8_STAGE(PG8_SB(1, 1), cB + hstep + kstep, voffB);
        PG8_WAIT_V(6); PG8_BAR;
    } else {
        PG8_STAGE(PG8_SB(0, 0), cB, voffB); PG8_STAGE(PG8_SA(0, 0), cA, voffA); PG8_STAGE(PG8_SB(0, 1), cB + hstep, voffB); PG8_STAGE(PG8_SA(0, 1), cA + hstep, voffA);
        if (wr == 1) PG8_BAR;
        PG8_WAIT_V(4); PG8_BAR;
        PG8_STAGE(PG8_SB(1, 0), cB + kstep, voffB); PG8_STAGE(PG8_SA(1, 0), cA + kstep, voffA); PG8_STAGE(PG8_SB(1, 1), cB + hstep + kstep, voffB);
        PG8_WAIT_V(6); PG8_BAR;
    }
    for (;;) {
        const bool has_next = S.next(ui + 1, nxt);
        const char* nA = has_next ? (const char*)g.A + (size_t)nxt.pm * tstep : cA; const char* nB = has_next ? (const char*)g.Bt + (size_t)nxt.pn * tstep : cB;
        for (int t = 0; t < nt; t += 2) {
            const bool last = (t == nt - 2);
            const char* a1 = cA + (size_t)(t + 1) * kstep;
            const char* a2 = last ? nA : cA + (size_t)(t + 2) * kstep; const char* b2 = last ? nB : cB + (size_t)(t + 2) * kstep;
            const char* a3 = a2 + kstep; const char* b3 = b2 + kstep;
            if (last && has_next) S.a_ready(nxt);
            if constexpr (SP2) {
            PG8_LDB(B0, 0, 0); PG8_LDB(B1, 0, 1); PG8_SCHED; PG8_LDA(At, 0, 0); PG8_STAGE(PG8_SA(1, 1), a1 + hstep, voffA);
            PG8_WAIT_V(8); PG8_WAIT_L(0); PG8_BAR; PG8_MMA(0, 0, At, B0); PG8_MMA(0, 1, At, B1); PG8_BAR; PG8_SCHED;
            PG8_LDA(At, 0, 1); PG8_STAGE(PG8_SB(0, 0), b2, voffB); PG8_STAGE(PG8_SB(0, 1), b2 + hstep, voffB); PG8_STAGE(PG8_SA(0, 0), a2, voffA);
            PG8_WAIT_V(8); PG8_WAIT_L(0); PG8_BAR; PG8_MMA(1, 0, At, B0); PG8_MMA(1, 1, At, B1); PG8_BAR; PG8_SCHED;
            PG8_LDB(B0, 1, 0); PG8_LDB(B1, 1, 1); PG8_SCHED; PG8_LDA(At, 1, 0); PG8_STAGE(PG8_SA(0, 1), a2 + hstep, voffA);
            PG8_WAIT_V(8); PG8_WAIT_L(0); PG8_BAR; PG8_MMA(0, 0, At, B0); PG8_MMA(0, 1, At, B1); PG8_BAR; PG8_SCHED;
            PG8_LDA(At, 1, 1); PG8_STAGE(PG8_SB(1, 0), b3, voffB); PG8_STAGE(PG8_SB(1, 1), b3 + hstep, voffB); PG8_STAGE(PG8_SA(1, 0), a3, voffA);
            PG8_WAIT_V(8); PG8_WAIT_L(0); PG8_BAR; PG8_MMA(1, 0, At, B0); PG8_MMA(1, 1, At, B1); PG8_BAR; PG8_SCHED;
            } else {
            PG8_LDB(B0, 0, 0); PG8_SCHED; PG8_LDA(At, 0, 0); PG8_STAGE(PG8_SA(1, 1), a1 + hstep, voffA);
            PG8_WAIT_L(8); PG8_BAR; PG8_WAIT_L(0); PG8_MMA(0, 0, At, B0); PG8_BAR; PG8_SCHED;
            PG8_LDB(B1, 0, 1); PG8_STAGE(PG8_SB(0, 0), b2, voffB);
            PG8_BAR; PG8_WAIT_L(0); PG8_MMA(0, 1, At, B1); PG8_BAR;
            PG8_LDA(At, 0, 1); PG8_STAGE(PG8_SA(0, 0), a2, voffA);
            PG8_BAR; PG8_WAIT_L(0); PG8_MMA(1, 0, At, B0); PG8_BAR; PG8_SCHED;
            PG8_STAGE(PG8_SB(0, 1), b2 + hstep, voffB);
            PG8_WAIT_V(6); PG8_BAR; PG8_MMA(1, 1, At, B1); PG8_BAR;
            PG8_LDB(B0, 1, 0); PG8_SCHED; PG8_LDA(At, 1, 0); PG8_STAGE(PG8_SA(0, 1), a2 + hstep, voffA);
            PG8_WAIT_L(8); PG8_BAR; PG8_WAIT_L(0); PG8_MMA(0, 0, At, B0); PG8_BAR; PG8_SCHED;
            PG8_LDB(B1, 1, 1); PG8_STAGE(PG8_SB(1, 0), b3, voffB);
            PG8_BAR; PG8_WAIT_L(0); PG8_MMA(0, 1, At, B1); PG8_BAR;
            PG8_LDA(At, 1, 1); PG8_STAGE(PG8_SA(1, 0), a3, voffA);
            PG8_BAR; PG8_WAIT_L(0); PG8_MMA(1, 0, At, B0); PG8_BAR; PG8_SCHED;
            PG8_STAGE(PG8_SB(1, 1), b3 + hstep, voffB);
            PG8_WAIT_V(6); PG8_BAR; PG8_MMA(1, 1, At, B1); PG8_BAR;
            }
        }
        if constexpr (ALIGN_EPI) { if (wr == 0) PG8_BAR; }
        if constexpr (!Epi::AFTER_DRAIN) { E(acc, cur, wr, wc, fr, fq); S.done(cur); }
        if (!has_next) break;
#pragma unroll
        for (int a = 0; a < 2; ++a)
#pragma unroll
            for (int b = 0; b < 2; ++b)
#pragma unroll
                for (int m = 0; m < 4; ++m)
#pragma unroll
                    for (int n = 0; n < 2; ++n) acc[a][b][m][n] = (f32x4){0.f, 0.f, 0.f, 0.f};
        cur = nxt; cA = nA; cB = nB; ++ui;
        if constexpr (ALIGN_EPI) { if (wr == 1) PG8_BAR; }
    }
    PG8_WAIT_V(0);
    if constexpr (!ALIGN_EPI) { if (wr == 0) PG8_BAR; }
    PG8_BAR;
    if constexpr (Epi::AFTER_DRAIN) { E.fused(acc, cur, wr, wc, fr, fq, lds, wid, lane); S.done(cur); }
#undef PG8_SA
#undef PG8_SB
#undef PG8_STAGE
#undef PG8_LDA
#undef PG8_LDB
#undef PG8_MMA
#undef PG8_WAIT_V
#undef PG8_WAIT_L
#undef PG8_BAR
#undef PG8_SCHED
}
}
using pg8::bf_lo; using pg8::bf_hi; using pg8::fast_sigmoid; using pg8::fast_silu;
#define PG8_SP2 true
#define PG8_ALIGN true
#define LAS __attribute__((address_space(3)))
typedef unsigned short bf16;
typedef unsigned v4u __attribute__((ext_vector_type(4)));
typedef unsigned v2u __attribute__((ext_vector_type(2)));
typedef float f32x4 __attribute__((ext_vector_type(4)));
typedef float f32x2 __attribute__((ext_vector_type(2)));
typedef short bf16x8 __attribute__((ext_vector_type(8)));
constexpr int DM = 2048, SEQ = 16384, NBATCH = 2, DECB = 16, DECS = 64;
constexpr int TP = NBATCH * SEQ, TS = DECB * DECS, TT = TP + TS;
constexpr int DCV = 1024, DH = 2048, NH = 16, DFF = 5632, DIN = 15360;
constexpr float EPS = 1e-6f;
constexpr int TGMAX = 17408;
constexpr size_t MiB = 1u << 20;
constexpr size_t WS_W1GU = 1 * MiB, WS_W1D = 45 * MiB, WS_WIN = 67 * MiB, WS_WBC = 127 * MiB, WS_WBH = 131 * MiB, WS_WOUT = 139 * MiB, WS_W2GU = 147 * MiB, WS_W2D = 191 * MiB;
constexpr size_t WS_XN = 213 * MiB, WS_BIG = 345 * MiB;
constexpr size_t WS_H = WS_BIG;
constexpr size_t WS_GB = WS_BIG, WS_GC = WS_GB + 34 * MiB, WS_VC = WS_GC + 34 * MiB, WS_Q = WS_VC + 34 * MiB, WS_FZ = WS_Q + 68 * MiB, WS_IV = WS_FZ + 68 * MiB,
                 WS_OG = WS_IV + 68 * MiB, WS_SGC = WS_OG + 68 * MiB, WS_SGH = WS_SGC + 68 * MiB, WS_UT = WS_SGH + 68 * MiB, WS_D = WS_UT + 136 * MiB, WS_END = WS_D + 5 * MiB;
static_assert(WS_END <= 1024 * MiB, "workspace map");
constexpr size_t O_Y = 0, O_NCP = (size_t)TT * DM, O_NHP = O_NCP + 2 * 2 * 1024, O_NCS = O_NHP + 2 * 16 * 16384, O_NHS = O_NCS + 16 * 2 * 1024;
constexpr int LDS_BYTES = 131072 + 1024;

__device__ __forceinline__ float wave_sum(float v) {
#pragma unroll
    for (int o = 1; o < 64; o <<= 1) v += __shfl_xor(v, o);
    return v;
}
__device__ __forceinline__ int opaque_tid() { int t = threadIdx.x; asm volatile("" : "+v"(t)); return t; }
__device__ __forceinline__ unsigned f2bf(float f) { unsigned u = __builtin_bit_cast(unsigned, f); return (u + 0x7fffu + ((u >> 16) & 1u)) >> 16; }
__device__ __forceinline__ unsigned pk2(float lo, float hi) { return pg8::cvt_pk_bf16(lo, hi); }

template <bool M5 = false> __device__ __forceinline__ void transpose_item(const float* W, int K, int N, bf16* WT, int il, LAS float* scr, int item, int lane) {
    const int nblk = N / 32, kb = item / nblk, nb = item % nblk, k0 = 64 * kb, n0 = 32 * nb;
#pragma unroll 8
    for (int i = 0; i < 32; ++i) { const int kk = 2 * i + (lane >> 5); scr[kk * 33 + (lane & 31)] = W[(size_t)(k0 + kk) * N + n0 + (lane & 31)]; }
    asm volatile("s_waitcnt lgkmcnt(0)" ::: "memory");
    const int c = lane & 7;
    const int r0 = il ? (256 * (n0 >> 7) + 128 * (il - 1) + (n0 & 127)) : n0;
#pragma unroll
    for (int j = 0; j < 4; ++j) { const int n = (lane >> 3) + 8 * j; const LAS float* s = scr + (8 * c) * 33 + n;
        v4u o; if (M5) { o.x = pk2(pg8::rnd_m5(s[0 * 33]), pg8::rnd_m5(s[1 * 33])); o.y = pk2(pg8::rnd_m5(s[2 * 33]), pg8::rnd_m5(s[3 * 33])); o.z = pk2(pg8::rnd_m5(s[4 * 33]), pg8::rnd_m5(s[5 * 33])); o.w = pk2(pg8::rnd_m5(s[6 * 33]), pg8::rnd_m5(s[7 * 33])); }
        else { o.x = pk2(s[0 * 33], s[1 * 33]); o.y = pk2(s[2 * 33], s[3 * 33]); o.z = pk2(s[4 * 33], s[5 * 33]); o.w = pk2(s[6 * 33], s[7 * 33]); }
        *(v4u*)(WT + (size_t)(r0 + n) * K + k0 + 8 * c) = o; }
    asm volatile("s_waitcnt lgkmcnt(0)" ::: "memory");
}
template <bool M5 = false> __device__ __forceinline__ void rms_rows_bf16(const float* xp, const float* xs, const float* gw, bf16* XN, int row_lo, int row_hi, int gwv, int ngw, int) {
    const int lane = opaque_tid() & 63;
    for (int m = row_lo + gwv; m < row_hi; m += ngw) {
        const f32x4* xr = (const f32x4*)(m < TP ? xp + (size_t)m * DM : xs + (size_t)(m - TP) * DM) + lane;
        f32x4 v[8]; float s = 0.f;
#pragma unroll
        for (int j = 0; j < 8; ++j) { v[j] = xr[64 * j]; s += (v[j].x * v[j].x + v[j].y * v[j].y) + (v[j].z * v[j].z + v[j].w * v[j].w); }
        const float r = 1.0f / sqrtf(wave_sum(s) * (1.0f / DM) + EPS);
        v2u* o = (v2u*)(XN + (size_t)m * DM) + lane;
#pragma unroll
        for (int j = 0; j < 8; ++j) { const f32x4 g = ((const f32x4*)gw)[lane + 64 * j]; f32x4 y = v[j] * r * g; if (M5) { y.x = pg8::rnd_m5(y.x); y.y = pg8::rnd_m5(y.y); y.z = pg8::rnd_m5(y.z); y.w = pg8::rnd_m5(y.w); } v2u w; w.x = pk2(y.x, y.y); w.y = pk2(y.z, y.w); o[64 * j] = w; }
    }
}
__device__ __forceinline__ void rms_rows_f32_inplace(float* x, const float* gw, int nrows, int gwv, int ngw, int) {
    const int lane = opaque_tid() & 63;
    for (int m = gwv; m < nrows; m += ngw) {
        f32x4* xr = (f32x4*)(x + (size_t)m * DM) + lane;
        f32x4 v[8]; float s = 0.f;
#pragma unroll
        for (int j = 0; j < 8; ++j) { v[j] = xr[64 * j]; s += (v[j].x * v[j].x + v[j].y * v[j].y) + (v[j].z * v[j].z + v[j].w * v[j].w); }
        const float r = 1.0f / sqrtf(wave_sum(s) * (1.0f / DM) + EPS);
#pragma unroll
        for (int j = 0; j < 8; ++j) { const f32x4 g = ((const f32x4*)gw)[lane + 64 * j]; xr[64 * j] = v[j] * r * g; }
    }
}

template <bool M5 = false> __device__ __forceinline__ void rms_rows_delta_bf16(const float* xp, const float* xs, const float* gw, bf16* XN, float* xout, int gwv, int ngw) {
    const int lane = opaque_tid() & 63;
    for (int m = gwv; m < TT; m += ngw) {
        const f32x4* xr = (const f32x4*)(m < TP ? xp + (size_t)m * DM : xs + (size_t)(m - TP) * DM) + lane;
        v2u* dn = (v2u*)(XN + (size_t)m * DM) + lane; f32x4* xo = (f32x4*)(xout + (size_t)m * DM) + lane;
        f32x4 v[8]; float s = 0.f;
#pragma unroll
        for (int j = 0; j < 8; ++j) { v[j] = xr[64 * j]; const v2u d = dn[64 * j]; v[j].x += bf_lo(d.x); v[j].y += bf_hi(d.x); v[j].z += bf_lo(d.y); v[j].w += bf_hi(d.y);
            s += (v[j].x * v[j].x + v[j].y * v[j].y) + (v[j].z * v[j].z + v[j].w * v[j].w); }
#pragma unroll
        for (int j = 0; j < 8; ++j) xo[64 * j] = v[j];
        const float r = 1.0f / sqrtf(wave_sum(s) * (1.0f / DM) + EPS);
#pragma unroll
        for (int j = 0; j < 8; ++j) { const f32x4 g = ((const f32x4*)gw)[lane + 64 * j]; f32x4 y = v[j] * r * g; if (M5) { y.x = pg8::rnd_m5(y.x); y.y = pg8::rnd_m5(y.y); y.z = pg8::rnd_m5(y.z); y.w = pg8::rnd_m5(y.w); } v2u w; w.x = pk2(y.x, y.y); w.y = pk2(y.z, y.w); dn[64 * j] = w; }
    }
}
__device__ __forceinline__ void rms_rows_delta_final(float* x, const bf16* XN, const float* gw, int gwv, int ngw) {
    const int lane = opaque_tid() & 63;
    for (int m = gwv; m < TT; m += ngw) {
        f32x4* xr = (f32x4*)(x + (size_t)m * DM) + lane; const v2u* dn = (const v2u*)(XN + (size_t)m * DM) + lane;
        f32x4 v[8]; float s = 0.f;
#pragma unroll
        for (int j = 0; j < 8; ++j) { v[j] = xr[64 * j]; const v2u d = dn[64 * j]; v[j].x += bf_lo(d.x); v[j].y += bf_hi(d.x); v[j].z += bf_lo(d.y); v[j].w += bf_hi(d.y);
            s += (v[j].x * v[j].x + v[j].y * v[j].y) + (v[j].z * v[j].z + v[j].w * v[j].w); }
        const float r = 1.0f / sqrtf(wave_sum(s) * (1.0f / DM) + EPS);
#pragma unroll
        for (int j = 0; j < 8; ++j) { const f32x4 g = ((const f32x4*)gw)[lane + 64 * j]; xr[64 * j] = v[j] * r * g; }
    }
}
__device__ __forceinline__ void conv_item(int cl, bool seq_first, bool seq_last, const float* hist  , float* newc  , bf16* GB, const bf16* GC, const bf16* VC, const float* cw, int) {
    const int tid = opaque_tid(); const int c0 = 8 * (tid & 127), tq = tid >> 7; const int r0 = cl * 64 + 16 * tq;
    float um2[8], um1[8], w0[8], w1[8], w2[8];
#pragma unroll
    for (int j = 0; j < 8; ++j) { w0[j] = cw[c0 + j]; w1[j] = cw[1024 + c0 + j]; w2[j] = cw[2048 + c0 + j]; }
    if (seq_first && tq == 0) {
#pragma unroll
        for (int j = 0; j < 8; ++j) { um2[j] = hist ? hist[c0 + j] : 0.f; um1[j] = hist ? hist[1024 + c0 + j] : 0.f; }
    } else {
        const v4u a2 = *(const v4u*)(GC + (size_t)(r0 - 2) * 1024 + c0), b2 = *(const v4u*)(VC + (size_t)(r0 - 2) * 1024 + c0);
        const v4u a1 = *(const v4u*)(GC + (size_t)(r0 - 1) * 1024 + c0), b1 = *(const v4u*)(VC + (size_t)(r0 - 1) * 1024 + c0);
#pragma unroll
        for (int j = 0; j < 4; ++j) { um2[2 * j] = bf_lo(a2[j]) * bf_lo(b2[j]); um2[2 * j + 1] = bf_hi(a2[j]) * bf_hi(b2[j]); um1[2 * j] = bf_lo(a1[j]) * bf_lo(b1[j]); um1[2 * j + 1] = bf_hi(a1[j]) * bf_hi(b1[j]); }
    }
#pragma unroll 4
    for (int i = 0; i < 16; ++i) {
        const size_t off = (size_t)(r0 + i) * 1024 + c0;
        const v4u g = *(const v4u*)(GB + off), a = *(const v4u*)(GC + off), b = *(const v4u*)(VC + off);
        float y[8];
#pragma unroll
        for (int j = 0; j < 4; ++j) {
            const float u0 = bf_lo(a[j]) * bf_lo(b[j]), u1 = bf_hi(a[j]) * bf_hi(b[j]);
            y[2 * j] = bf_lo(g[j]) * (w0[2 * j] * um2[2 * j] + w1[2 * j] * um1[2 * j] + w2[2 * j] * u0);
            y[2 * j + 1] = bf_hi(g[j]) * (w0[2 * j + 1] * um2[2 * j + 1] + w1[2 * j + 1] * um1[2 * j + 1] + w2[2 * j + 1] * u1);
            um2[2 * j] = um1[2 * j]; um1[2 * j] = u0; um2[2 * j + 1] = um1[2 * j + 1]; um1[2 * j + 1] = u1;
        }
        v4u w; w.x = pk2(y[0], y[1]); w.y = pk2(y[2], y[3]); w.z = pk2(y[4], y[5]); w.w = pk2(y[6], y[7]);
        *(v4u*)(GB + off) = w;
    }
    if (seq_last && tq == 3) {
#pragma unroll
        for (int j = 0; j < 8; ++j) { newc[c0 + j] = um2[j]; newc[1024 + c0 + j] = um1[j]; }
    }
}

constexpr int H1_QD = 0, H1_KI = 17408, H1_KET = 34816, H1_VT = 53248, H1_A = 71680, H1_TOT = 80896;
__device__ __forceinline__ void h1_unit(LAS unsigned char* lds, int row0, int h, bf16* Q, bf16* FZ, const bf16* IV, bf16* UTu, float* Du, const float* lbl, int) {
    const int tid = opaque_tid(); LAS bf16* sQd = (LAS bf16*)(lds + H1_QD); LAS bf16* sKi = (LAS bf16*)(lds + H1_KI); LAS bf16* sKet = (LAS bf16*)(lds + H1_KET);
    LAS bf16* sVt = (LAS bf16*)(lds + H1_VT); LAS bf16* sA = (LAS bf16*)(lds + H1_A); LAS float* sTot = (LAS float*)(lds + H1_TOT);
    const int lane = tid & 63, w = tid >> 6, k0 = 2 * lane, fr = lane & 15, fq = lane >> 4;
    const float la0 = lbl[h * 128 + k0], la1 = lbl[h * 128 + k0 + 1], lb0_ = lbl[2048 + h * 128 + k0], lb1_ = lbl[2048 + h * 128 + k0 + 1];
    const float lbv0 = 1.0f / (1.0f + __expf(lb0_ - la0)), lbv1 = 1.0f / (1.0f + __expf(lb1_ - la1));
    const size_t gbase = (size_t)(row0 + 8 * w) * 2048 + h * 128 + k0;
    unsigned qv[8], fv[8], vv[8];
#pragma unroll
    for (int i = 0; i < 8; ++i) { qv[i] = *(const unsigned*)(Q + gbase + (size_t)i * 2048); fv[i] = *(const unsigned*)(FZ + gbase + (size_t)i * 2048); vv[i] = *(const unsigned*)(IV + gbase + (size_t)i * 2048); }
    float g0[8], g1[8], kk0[8], kk1[8]; float c0 = 0.f, c1 = 0.f;
#pragma unroll
    for (int i = 0; i < 8; ++i) {
        const float z0 = fminf(fmaxf(bf_lo(fv[i]), -30.f), 30.f), z1 = fminf(fmaxf(bf_hi(fv[i]), -30.f), 30.f);
        const float e0 = __builtin_amdgcn_exp2f(-1.44269504f * z0), e1 = __builtin_amdgcn_exp2f(-1.44269504f * z1);
        const float s0 = __builtin_amdgcn_rcpf(1.f + e0), s1 = __builtin_amdgcn_rcpf(1.f + e1);
        const float f0 = lbv0 + (1.f - lbv0) * s0, f1 = lbv1 + (1.f - lbv1) * s1;
        kk0[i] = (1.f - lbv0) * e0 * s0; kk1[i] = (1.f - lbv1) * e1 * s1;
        c0 += __builtin_amdgcn_logf(f0); c1 += __builtin_amdgcn_logf(f1); g0[i] = c0; g1[i] = c1;
    }
    sTot[w * 128 + k0] = c0; sTot[w * 128 + k0 + 1] = c1;
    __syncthreads();
    float off0 = 0.f, off1 = 0.f, tot0 = 0.f, tot1 = 0.f;
#pragma unroll
    for (int j = 0; j < 8; ++j) { const float t0 = sTot[j * 128 + k0], t1 = sTot[j * 128 + k0 + 1]; tot0 += t0; tot1 += t1; if (j < w) { off0 += t0; off1 += t1; } }
    float ke0[8], ke1[8];
#pragma unroll
    for (int i = 0; i < 8; ++i) {
        const float G0 = off0 + g0[i], G1 = off1 + g1[i];
        const float q0 = bf_lo(qv[i]), q1 = bf_hi(qv[i]);
        const unsigned qd = pk2(q0 * __builtin_amdgcn_exp2f(G0), q1 * __builtin_amdgcn_exp2f(G1));
        const unsigned ki = pk2(kk0[i] * __builtin_amdgcn_exp2f(-G0), kk1[i] * __builtin_amdgcn_exp2f(-G1));
        ke0[i] = kk0[i] * __builtin_amdgcn_exp2f(tot0 - G0); ke1[i] = kk1[i] * __builtin_amdgcn_exp2f(tot1 - G1);
        *(LAS unsigned*)(sQd + (8 * w + i) * 136 + k0) = qd; *(LAS unsigned*)(sKi + (8 * w + i) * 136 + k0) = ki;
        *(unsigned*)(Q + gbase + (size_t)i * 2048) = qd;
    }
    { v4u a, b, c, d;
      a.x = pk2(ke0[0], ke0[1]); a.y = pk2(ke0[2], ke0[3]); a.z = pk2(ke0[4], ke0[5]); a.w = pk2(ke0[6], ke0[7]);
      b.x = pk2(ke1[0], ke1[1]); b.y = pk2(ke1[2], ke1[3]); b.z = pk2(ke1[4], ke1[5]); b.w = pk2(ke1[6], ke1[7]);
#pragma unroll
      for (int j = 0; j < 4; ++j) { c[j] = (vv[2 * j] & 0xffffu) | (vv[2 * j + 1] << 16); d[j] = (vv[2 * j] >> 16) | (vv[2 * j + 1] & 0xffff0000u); }
      *(LAS v4u*)(sKet + k0 * 72 + 8 * w) = a; *(LAS v4u*)(sKet + (k0 + 1) * 72 + 8 * w) = b;
      *(LAS v4u*)(sVt + k0 * 72 + 8 * w) = c; *(LAS v4u*)(sVt + (k0 + 1) * 72 + 8 * w) = d; }
    if (w == 0) { f32x2 dd; dd.x = __builtin_amdgcn_exp2f(tot0); dd.y = __builtin_amdgcn_exp2f(tot1); *(f32x2*)(Du + k0) = dd; }
    __syncthreads();
#pragma unroll
    for (int tt = 0; tt < 2; ++tt) {
        const int tile = 2 * w + tt, li = tile >> 2, si = tile & 3;
        f32x4 acc = (f32x4){0.f, 0.f, 0.f, 0.f};
        if (si <= li) {
#pragma unroll
            for (int ks = 0; ks < 4; ++ks) { const bf16x8 a = *(const LAS bf16x8*)(sQd + (li * 16 + fr) * 136 + ks * 32 + fq * 8), b = *(const LAS bf16x8*)(sKi + (si * 16 + fr) * 136 + ks * 32 + fq * 8);
                acc = __builtin_amdgcn_mfma_f32_16x16x32_bf16(a, b, acc, 0, 0, 0); }
        }
#pragma unroll
        for (int j = 0; j < 4; ++j) { const int l = li * 16 + fq * 4 + j, s = si * 16 + fr; const float v = (s <= l) ? acc[j] : 0.f; sA[l * 72 + s] = (bf16)f2bf(v); }
    }
    __syncthreads();
    {   const int vi = w;
#pragma unroll
        for (int li = 0; li < 4; ++li) { f32x4 acc = (f32x4){0.f, 0.f, 0.f, 0.f};
#pragma unroll
            for (int ks = 0; ks < 2; ++ks) { const bf16x8 a = *(const LAS bf16x8*)(sVt + (vi * 16 + fr) * 72 + ks * 32 + fq * 8), b = *(const LAS bf16x8*)(sA + (li * 16 + fr) * 72 + ks * 32 + fq * 8);
                acc = __builtin_amdgcn_mfma_f32_16x16x32_bf16(a, b, acc, 0, 0, 0); }
            v2u o; o.x = pk2(acc[0], acc[1]); o.y = pk2(acc[2], acc[3]);
            *(v2u*)(FZ + (size_t)(row0 + li * 16 + fr) * 2048 + h * 128 + vi * 16 + fq * 4) = o; }
#pragma unroll
        for (int ki = 0; ki < 8; ++ki) { f32x4 acc = (f32x4){0.f, 0.f, 0.f, 0.f};
#pragma unroll
            for (int ks = 0; ks < 2; ++ks) { const bf16x8 a = *(const LAS bf16x8*)(sKet + (ki * 16 + fr) * 72 + ks * 32 + fq * 8), b = *(const LAS bf16x8*)(sVt + (vi * 16 + fr) * 72 + ks * 32 + fq * 8);
                acc = __builtin_amdgcn_mfma_f32_16x16x32_bf16(a, b, acc, 0, 0, 0); }
            v2u o; o.x = pk2(acc[0], acc[1]); o.y = pk2(acc[2], acc[3]);
            *(v2u*)(UTu + (size_t)(vi * 16 + fr) * 128 + ki * 16 + fq * 4) = o; }
    }
}
constexpr int H3_Q = 0, H3_S = 17408, H3_SS = 52224;
__device__ __forceinline__ void h3_unit(LAS unsigned char* lds, int row0, int h, const bf16* Q, const bf16* FZ, bf16* OG, const bf16* UTu, const float* hnorm, int) {
    const int tid = opaque_tid(); LAS bf16* sQ = (LAS bf16*)(lds + H3_Q); LAS bf16* sS = (LAS bf16*)(lds + H3_S); LAS float* sSS = (LAS float*)(lds + H3_SS);
    const int lane = tid & 63, w = tid >> 6, fr = lane & 15, fq = lane >> 4;
    { const int r = tid >> 3, sg = tid & 7; const v4u* src = (const v4u*)(Q + (size_t)(row0 + r) * 2048 + h * 128 + sg * 16); const v4u a = src[0], b = src[1];
      const int v = tid >> 2, s4 = tid & 3; const v4u* s2 = (const v4u*)(UTu + (size_t)v * 128 + s4 * 32); const v4u c0 = s2[0], c1 = s2[1], c2 = s2[2], c3 = s2[3];
      *(LAS v4u*)(sQ + r * 136 + sg * 16) = a; *(LAS v4u*)(sQ + r * 136 + sg * 16 + 8) = b;
      *(LAS v4u*)(sS + v * 136 + s4 * 32) = c0; *(LAS v4u*)(sS + v * 136 + s4 * 32 + 8) = c1; *(LAS v4u*)(sS + v * 136 + s4 * 32 + 16) = c2; *(LAS v4u*)(sS + v * 136 + s4 * 32 + 24) = c3; }
    __syncthreads();
    const int vi = w; f32x4 o[4];
#pragma unroll
    for (int li = 0; li < 4; ++li) { f32x4 acc = (f32x4){0.f, 0.f, 0.f, 0.f};
#pragma unroll
        for (int ks = 0; ks < 4; ++ks) { const bf16x8 a = *(const LAS bf16x8*)(sS + (vi * 16 + fr) * 136 + ks * 32 + fq * 8), b = *(const LAS bf16x8*)(sQ + (li * 16 + fr) * 136 + ks * 32 + fq * 8);
            acc = __builtin_amdgcn_mfma_f32_16x16x32_bf16(a, b, acc, 0, 0, 0); }
        const v2u oi = *(const v2u*)(FZ + (size_t)(row0 + li * 16 + fr) * 2048 + h * 128 + vi * 16 + fq * 4);
        acc[0] += bf_lo(oi.x); acc[1] += bf_hi(oi.x); acc[2] += bf_lo(oi.y); acc[3] += bf_hi(oi.y);
        o[li] = acc;
        float ss = (acc[0] * acc[0] + acc[1] * acc[1]) + (acc[2] * acc[2] + acc[3] * acc[3]);
        ss += __shfl_xor(ss, 16); ss += __shfl_xor(ss, 32);
        if (fq == 0) sSS[w * 64 + li * 16 + fr] = ss; }
    __syncthreads();
    const f32x4 hn = *(const f32x4*)(hnorm + h * 128 + vi * 16 + fq * 4);
#pragma unroll
    for (int li = 0; li < 4; ++li) { const int l = li * 16 + fr; float t = 0.f;
#pragma unroll
        for (int j = 0; j < 8; ++j) t += sSS[j * 64 + l];
        const float r = 1.0f / sqrtf(t * (1.0f / 128.0f) + EPS);
        bf16* p = OG + (size_t)(row0 + l) * 2048 + h * 128 + vi * 16 + fq * 4; const v2u sg = *(const v2u*)p;
        v2u y; y.x = pk2(o[li][0] * r * hn.x * bf_lo(sg.x), o[li][1] * r * hn.y * bf_hi(sg.x)); y.y = pk2(o[li][2] * r * hn.z * bf_lo(sg.y), o[li][3] * r * hn.w * bf_hi(sg.y));
        *(v2u*)p = y; }
}
__device__ __forceinline__ void scan_prompt(bf16* UT, const float* D, float* out_state  , int gbase, int gthreads) {
    const int gtid = gbase + opaque_tid();
    for (int e = gtid; e < 16 * 128 * 16; e += gthreads) {
        const int h = e >> 11, rem = e & 2047, v = rem >> 4, k = 8 * (rem & 15);
        bf16* up = UT + (size_t)h * 16384 + v * 128 + k; const float* dp = D + h * 128 + k;
        float s[8];
#pragma unroll
        for (int j = 0; j < 8; ++j) s[j] = 0.f;
        for (int c0 = 0; c0 < 256; c0 += 8) {
            v4u u[8]; f32x4 d0[8], d1[8];
#pragma unroll
            for (int i = 0; i < 8; ++i) { u[i] = *(const v4u*)(up + (size_t)(c0 + i) * 16 * 16384); d0[i] = *(const f32x4*)(dp + (size_t)(c0 + i) * 16 * 128); d1[i] = *(const f32x4*)(dp + (size_t)(c0 + i) * 16 * 128 + 4); }
#pragma unroll
            for (int i = 0; i < 8; ++i) {
                v4u o; o.x = pk2(s[0], s[1]); o.y = pk2(s[2], s[3]); o.z = pk2(s[4], s[5]); o.w = pk2(s[6], s[7]);
                *(v4u*)(up + (size_t)(c0 + i) * 16 * 16384) = o;
                s[0] = d0[i].x * s[0] + bf_lo(u[i].x); s[1] = d0[i].y * s[1] + bf_hi(u[i].x); s[2] = d0[i].z * s[2] + bf_lo(u[i].y); s[3] = d0[i].w * s[3] + bf_hi(u[i].y);
                s[4] = d1[i].x * s[4] + bf_lo(u[i].z); s[5] = d1[i].y * s[5] + bf_hi(u[i].z); s[6] = d1[i].z * s[6] + bf_lo(u[i].w); s[7] = d1[i].w * s[7] + bf_hi(u[i].w);
            }
        }
#pragma unroll
        for (int j = 0; j < 8; ++j) out_state[((size_t)h * 128 + k + j) * 128 + v] = s[j];
    }
}
__device__ __forceinline__ void scan_sample(bf16* UT  , const float* D, const float* st_in, float* st_out, int gbase, int gthreads) {
    const int gtid = gbase + opaque_tid();
    for (int e = gtid; e < 16 * 16 * 128 * 16; e += gthreads) {
        const int bh = e >> 11, rem = e & 2047, v = rem >> 4, k = 8 * (rem & 15);
        bf16* up = UT + (size_t)bh * 16384 + v * 128 + k; const f32x4 d0 = *(const f32x4*)(D + bh * 128 + k), d1 = *(const f32x4*)(D + bh * 128 + k + 4);
        const size_t si = ((size_t)bh * 128 + k) * 128 + v;
        float a[8];
#pragma unroll
        for (int j = 0; j < 8; ++j) a[j] = st_in[si + (size_t)j * 128];
        const v4u u = *(const v4u*)up;
        v4u o; o.x = pk2(a[0], a[1]); o.y = pk2(a[2], a[3]); o.z = pk2(a[4], a[5]); o.w = pk2(a[6], a[7]);
        *(v4u*)up = o;
        st_out[si] = d0.x * a[0] + bf_lo(u.x); st_out[si + 128] = d0.y * a[1] + bf_hi(u.x); st_out[si + 256] = d0.z * a[2] + bf_lo(u.y); st_out[si + 384] = d0.w * a[3] + bf_hi(u.y);
        st_out[si + 512] = d1.x * a[4] + bf_lo(u.z); st_out[si + 640] = d1.y * a[5] + bf_hi(u.z); st_out[si + 768] = d1.z * a[6] + bf_lo(u.w); st_out[si + 896] = d1.w * a[7] + bf_hi(u.w);
    }
}

#define RLX_AGENT __ATOMIC_RELAXED, __HIP_MEMORY_SCOPE_AGENT
#define XB_TMO      128
#define XB_XCNT(j)  (256  + 64 * (j))
#define XB_XSUB(j)  (1280 + 64 * (j))
#define XB_XGEN(j)  (2304 + 64 * (j))
#define XB_TOP      3328
#define XB_TOPGEN   3392
#define XCD_BAR_WORDS 3456
#define XB_SPIN_CAP (1u << 18)

__device__ __forceinline__ unsigned xb_ld(unsigned* p)              { return __hip_atomic_load(p, __ATOMIC_RELAXED, __HIP_MEMORY_SCOPE_AGENT); }
__device__ __forceinline__ unsigned xb_add(unsigned* p, unsigned v) { return __hip_atomic_fetch_add(p, v, __ATOMIC_RELAXED, __HIP_MEMORY_SCOPE_AGENT); }
__device__ __forceinline__ unsigned xb_xcc_id() { return (unsigned)__builtin_amdgcn_s_getreg((3 << 11) | 20) & 0xFu; }
#define XB_SPIN(cond, bar) do { unsigned _sp = 0; while (cond) { __builtin_amdgcn_s_sleep(1); \
    if ((++_sp & 255u) == 0u) { if (xb_ld(&(bar)[XB_TMO])) break; if (_sp > XB_SPIN_CAP) { atomicAdd(&(bar)[XB_TMO], 1u); break; } } } } while (0)

struct XcdBarrier {
    unsigned* bar; unsigned x;
    volatile LAS unsigned* st;
};

__device__ __forceinline__ XcdBarrier xcd_barrier_post(unsigned* bar, volatile LAS unsigned* st) {
    XcdBarrier b; b.bar = bar; b.x = xb_xcc_id(); b.st = st;
    if (threadIdx.x == 0) (void)xb_add(&bar[XB_XCNT(b.x)], 1u);
    return b;
}
__device__ __forceinline__ void xcd_barrier_complete(unsigned* bar, unsigned x, unsigned& nloc, unsigned& nx) {
    const unsigned G = gridDim.x * gridDim.y * gridDim.z;
    unsigned sum, cnt, mine, sp = 0u;
    for (;;) {
        sum = 0u; cnt = 0u; mine = 0u;
#pragma unroll
        for (unsigned j = 0; j < 16; ++j) { const unsigned c = xb_ld(&bar[XB_XCNT(j)]); sum += c; cnt += (c > 0u) ? 1u : 0u; mine = (j == x) ? c : mine; }
        if (sum == G) break;
        __builtin_amdgcn_s_sleep(1);
        if ((++sp & 255u) == 0u) { if (xb_ld(&bar[XB_TMO])) break; if (sp > XB_SPIN_CAP) { atomicAdd(&bar[XB_TMO], 1u); break; } }
    }
    nloc = mine > 0u ? mine : 1u; nx = cnt > 0u ? cnt : 1u;
}

__device__ __forceinline__ void xcd_barrier(const XcdBarrier& b) {
    asm volatile("s_waitcnt vmcnt(0)" ::: "memory");
    __syncthreads();
    if (threadIdx.x == 0) {
        unsigned* bar = b.bar;
        __builtin_amdgcn_s_waitcnt(0);
        unsigned nloc = b.st[0], nx = b.st[1];
        if (nloc == 0u) { xcd_barrier_complete(bar, b.x, nloc, nx); b.st[0] = nloc; b.st[1] = nx; }
        const unsigned old = xb_add(&bar[XB_XSUB(b.x)], 1u);
        const unsigned gen = old / nloc;
        if (old + 1u == (gen + 1u) * nloc) {
            __builtin_amdgcn_fence(__ATOMIC_RELEASE, "agent");
            asm volatile("s_waitcnt vmcnt(0)" ::: "memory");
            const unsigned og = xb_add(&bar[XB_TOP], 1u);
            const unsigned tg = og / nx;
            if (og + 1u == (tg + 1u) * nx) xb_add(&bar[XB_TOPGEN], 1u);
            else XB_SPIN(xb_ld(&bar[XB_TOPGEN]) == tg, bar);
            __builtin_amdgcn_fence(__ATOMIC_ACQUIRE, "agent");
            xb_add(&bar[XB_XGEN(b.x)], 1u);
            asm volatile("s_waitcnt vmcnt(0)" ::: "memory");
        } else {
            XB_SPIN(xb_ld(&bar[XB_XGEN(b.x)]) == gen, bar);
            __builtin_amdgcn_fence(__ATOMIC_ACQUIRE, "agent");
            asm volatile("s_waitcnt vmcnt(0)" ::: "memory");
        }
    }
    __syncthreads();
}

__device__ __forceinline__ int tid_k() { return threadIdx.x; }
__device__ __forceinline__ LAS unsigned char* lds_raw_las(unsigned char* p) { return (LAS unsigned char*)p; }
struct Args { const float* in[21]; float* out; unsigned char* ws; };
__global__ void __launch_bounds__(512, 2) mk_fwd(Args a) {
    extern __shared__ __attribute__((aligned(16))) unsigned char lds_raw[];
    cg::grid_group grid = cg::this_grid();
    for (int u = tid_k(); u < 256; u += 512) ((LAS unsigned*)(lds_raw_las(lds_raw) + 131072))[u] = 0u;
    __syncthreads();
    XcdBarrier bar = xcd_barrier_post((unsigned*)a.ws, (volatile LAS unsigned*)(lds_raw_las(lds_raw) + 131072));
    asm volatile("s_waitcnt vmcnt(0) lgkmcnt(0)" ::: "memory"); grid.sync();
#define GRID_SYNC() xcd_barrier(bar)
    LAS unsigned char* lds = (LAS unsigned char*)lds_raw;
    const int tid = threadIdx.x, lane = tid & 63, wave = __builtin_amdgcn_readfirstlane(tid >> 6);
    const int G = gridDim.x, bx = blockIdx.x;
    const int vcu = (G % 8 == 0) ? (bx % 8) * (G / 8) + bx / 8 : bx;
    const int gw = vcu * 8 + wave, NGW = G * 8;
    unsigned char* ws = a.ws; float* out = a.out;
    bf16* W1GU = (bf16*)(ws + WS_W1GU); bf16* W1D = (bf16*)(ws + WS_W1D); bf16* WIN = (bf16*)(ws + WS_WIN); bf16* WBC = (bf16*)(ws + WS_WBC); bf16* WBH = (bf16*)(ws + WS_WBH);
    bf16* WOUT = (bf16*)(ws + WS_WOUT); bf16* W2GU = (bf16*)(ws + WS_W2GU); bf16* W2D = (bf16*)(ws + WS_W2D);
    bf16* XN = (bf16*)(ws + WS_XN); bf16* HB = (bf16*)(ws + WS_H);
    bf16* GB = (bf16*)(ws + WS_GB); bf16* GC = (bf16*)(ws + WS_GC); bf16* VC = (bf16*)(ws + WS_VC); bf16* QB = (bf16*)(ws + WS_Q); bf16* FZ = (bf16*)(ws + WS_FZ); bf16* IV = (bf16*)(ws + WS_IV);
    bf16* OG = (bf16*)(ws + WS_OG); bf16* SGC = (bf16*)(ws + WS_SGC); bf16* SGH = (bf16*)(ws + WS_SGH); bf16* UT = (bf16*)(ws + WS_UT); float* DD = (float*)(ws + WS_D);
    bf16* MG = QB;

    {
        LAS float* scr = (LAS float*)(lds + wave * 16384);
        constexpr int I_F = (DM / 64) * (DFF / 32), I_D = (DFF / 64) * (DM / 32), I_IN = (DM / 64) * (DIN / 32), I_BC = (DCV / 64) * (DM / 32), I_SQ = (DM / 64) * (DM / 32);
        constexpr int NITEMS = 4 * I_F + 2 * I_D + I_IN + I_BC + 2 * I_SQ;
        for (int it = gw; it < NITEMS; it += NGW) {
            int r = it;
            if (r < I_F) { transpose_item<true>(a.in[5], DM, DFF, W1GU, 1, scr, r, lane); continue; } r -= I_F;
            if (r < I_F) { transpose_item<true>(a.in[6], DM, DFF, W1GU, 2, scr, r, lane); continue; } r -= I_F;
            if (r < I_D) { transpose_item<true>(a.in[7], DFF, DM, W1D, 0, scr, r, lane); continue; } r -= I_D;
            if (r < I_IN) { transpose_item(a.in[9], DM, DIN, WIN, 0, scr, r, lane); continue; } r -= I_IN;
            if (r < I_BC) { transpose_item(a.in[13], DCV, DM, WBC, 0, scr, r, lane); continue; } r -= I_BC;
            if (r < I_SQ) { transpose_item(a.in[14], DH, DM, WBH, 0, scr, r, lane); continue; } r -= I_SQ;
            if (r < I_SQ) { transpose_item(a.in[15], DM, DM, WOUT, 0, scr, r, lane); continue; } r -= I_SQ;
            if (r < I_F) { transpose_item<true>(a.in[17], DM, DFF, W2GU, 1, scr, r, lane); continue; } r -= I_F;
            if (r < I_F) { transpose_item<true>(a.in[18], DM, DFF, W2GU, 2, scr, r, lane); continue; } r -= I_F;
            transpose_item<true>(a.in[19], DFF, DM, W2D, 0, scr, r, lane);
        }
        rms_rows_bf16<true>(a.in[0], a.in[1], a.in[4], XN, 0, TT, gw, NGW, lane);
    }
    GRID_SYNC();
    { pg8::Gemm g{XN, W1GU, TT, 2 * DFF, DM}; pg8::StaticOrder S; S.init(TT, 2 * DFF, G, bx); pg8::EpiSwiGLU E{HB, DFF};
      pg8::gemm_phase<pg8::EpiSwiGLU, pg8::StaticOrder, PG8_ALIGN, PG8_SP2>(lds, g, S, E); }
    GRID_SYNC();
    { pg8::Gemm g{HB, W1D, TT, DM, DFF}; pg8::StaticOrder S; S.init(TT, DM, G, bx); pg8::EpiDelta E{XN, DM, 0.5f};
      pg8::gemm_phase<pg8::EpiDelta, pg8::StaticOrder, PG8_ALIGN, PG8_SP2>(lds, g, S, E); }
    GRID_SYNC();
    rms_rows_delta_bf16(a.in[0], a.in[1], a.in[8], XN, out, gw, NGW);
    GRID_SYNC();
    for (int grp = 0; grp < 2; ++grp) {
        const int tok0 = grp ? SEQ : 0, Tg = grp ? (SEQ + TS) : SEQ, nch = Tg / 64;
        { pg8::Gemm g{XN + (size_t)tok0 * DM, WIN, Tg, DIN, DM}; pg8::StaticOrder S; S.init(Tg, DIN, G, bx); pg8::EpiProj E{GB, GC, VC, QB, FZ, IV, OG, SGC, SGH};
          pg8::gemm_phase<pg8::EpiProj, pg8::StaticOrder, PG8_ALIGN, PG8_SP2>(lds, g, S, E); }
        GRID_SYNC();
        for (int cl = vcu; cl < nch; cl += G) {
            const bool smp = cl >= 256; const int bs = cl - 256;
            const float* hist = smp ? a.in[2] + (size_t)bs * 2048 : nullptr;
            float* newc = smp ? out + O_NCS + (size_t)bs * 2048 : out + O_NCP + (size_t)grp * 2048;
            conv_item(cl, smp || cl == 0, smp || cl == 255, hist, newc, GB, GC, VC, a.in[10], tid);
        }
        for (int ul = vcu; ul < nch * 16; ul += G) {
            const int cl = ul >> 4, h = ul & 15;
            h1_unit(lds, cl * 64, h, QB, FZ, IV, UT + (size_t)ul * 16384, DD + (size_t)ul * 128, a.in[11], tid);
        }
        GRID_SYNC();
        scan_prompt(UT, DD, out + O_NHP + (size_t)grp * 16 * 16384, vcu * 512, G * 512);
        if (grp) scan_sample(UT + (size_t)256 * 16 * 16384, DD + (size_t)256 * 16 * 128, a.in[3], out + O_NHS, vcu * 512, G * 512);
        GRID_SYNC();
        for (int ul = vcu; ul < nch * 16; ul += G) {
            const int cl = ul >> 4, h = ul & 15;
            h3_unit(lds, cl * 64, h, QB, FZ, OG, UT + (size_t)ul * 16384, a.in[12], tid);
        }
        GRID_SYNC();
        { pg8::StaticOrder S; S.init(Tg, DM, G, bx);
          { pg8::Gemm g{GB, WBC, Tg, DM, DCV}; pg8::EpiMerge<false> E{SGC, MG}; pg8::gemm_phase<pg8::EpiMerge<false>, pg8::StaticOrder, PG8_ALIGN, PG8_SP2>(lds, g, S, E); }
          { pg8::Gemm g{OG, WBH, Tg, DM, DH}; pg8::EpiMerge<true> E{SGH, MG}; pg8::gemm_phase<pg8::EpiMerge<true>, pg8::StaticOrder, PG8_ALIGN, PG8_SP2>(lds, g, S, E); } }
        GRID_SYNC();
        { float* xo = out + (size_t)tok0 * DM; pg8::Gemm g{MG, WOUT, Tg, DM, DM}; pg8::StaticOrder S; S.init(Tg, DM, G, bx); pg8::EpiDelta E{XN + (size_t)tok0 * DM, DM, 1.0f};
          (void)xo; pg8::gemm_phase<pg8::EpiDelta, pg8::StaticOrder, PG8_ALIGN, PG8_SP2>(lds, g, S, E); }
        GRID_SYNC();
    }
    rms_rows_delta_bf16<true>(out, out + (size_t)TP * DM, a.in[16], XN, out, gw, NGW);
    GRID_SYNC();
    { pg8::Gemm g{XN, W2GU, TT, 2 * DFF, DM}; pg8::StaticOrder S; S.init(TT, 2 * DFF, G, bx); pg8::EpiSwiGLU E{HB, DFF};
      pg8::gemm_phase<pg8::EpiSwiGLU, pg8::StaticOrder, PG8_ALIGN, PG8_SP2>(lds, g, S, E); }
    GRID_SYNC();
    { pg8::Gemm g{HB, W2D, TT, DM, DFF}; pg8::StaticOrder S; S.init(TT, DM, G, bx); pg8::EpiDelta E{XN, DM, 0.5f};
      pg8::gemm_phase<pg8::EpiDelta, pg8::StaticOrder, PG8_ALIGN, PG8_SP2>(lds, g, S, E); }
    GRID_SYNC();
    rms_rows_delta_final(out, XN, a.in[20], gw, NGW);
}

extern "C" void kernel_launch(void* const* d_in, const int* in_sizes, int n_in, void* d_out, int out_size, void* d_ws, size_t ws_size, hipStream_t stream) {
    static int grid = 0;
    if (grid == 0) {
        if (n_in != 21 || ws_size < WS_END) { fprintf(stderr, "kernel_launch: unexpected n_in %d / ws_size %zu (need %zu)\n", n_in, ws_size, (size_t)WS_END); grid = -1; return; }
        int dev = 0, cus = 0, per_cu = 0;
        hipGetDevice(&dev); hipDeviceGetAttribute(&cus, hipDeviceAttributeMultiprocessorCount, dev);
        if (hipFuncSetAttribute((const void*)mk_fwd, hipFuncAttributeMaxDynamicSharedMemorySize, LDS_BYTES) != hipSuccess) { fprintf(stderr, "kernel_launch: hipFuncSetAttribute failed\n"); grid = -1; return; }
        if (hipOccupancyMaxActiveBlocksPerMultiprocessor(&per_cu, (const void*)mk_fwd, 512, LDS_BYTES) != hipSuccess || per_cu < 1) { fprintf(stderr, "kernel_launch: occupancy query says %d\n", per_cu); per_cu = 1; }
        (void)hipGetLastError();
        grid = cus * 1;
        (void)per_cu;
    }
    if (grid < 0) return;
    if (hipMemsetAsync(d_ws, 0, 16384, stream) != hipSuccess) { fprintf(stderr, "kernel_launch: hipMemsetAsync failed\n"); return; }
    Args a{};
    for (int i = 0; i < 21; ++i) a.in[i] = (const float*)d_in[i];
    a.out = (float*)d_out; a.ws = (unsigned char*)d_ws;
    void* args[] = {&a};
    hipError_t e = hipLaunchCooperativeKernel((const void*)mk_fwd, dim3(grid), dim3(512), args, LDS_BYTES, stream);
    if (e != hipSuccess) fprintf(stderr, "kernel_launch: cooperative launch failed: %s (grid %d)\n", hipGetErrorString(e), grid);
}
```
